# Optimizing an MI355X kernel written in HIP

```python
import math
import jax
import jax.numpy as jnp
from jax import lax
import numpy as np

D_MODEL = 1024
BATCH = 32
SEQ = 2048
DEPTH = 2
DEC_BATCH = 32
DEC_SEQ = 16
PAST_LEN = 4096

CHUNK = 64
Q_BLOCK = 128
N_EVEN = (DEPTH + 1) // 2
N_ODD = DEPTH // 2
EPS = 1e-6

SB_HEADS = 8
SB_HEAD_DIM = 64
SB_WIDTH = SB_HEADS * SB_HEAD_DIM
SB_SCALE = 1.0 / math.sqrt(SB_HEAD_DIM)

CONV_DIM = D_MODEL // 2
CONV_W = 3

SGU_CHUNK = 128
SGU_GROUPS = 4
SGU_DIM = D_MODEL // 2
SGU_GROUP_DIM = SGU_DIM // SGU_GROUPS

MLA_HEADS = 8
Q_LORA = 384
KV_LORA = 256
NOPE_DIM = 64
ROPE_DIM = 32
V_DIM = 64
ROPE_THETA = 10000.0
MLA_SCALE = 1.0 / math.sqrt(NOPE_DIM + ROPE_DIM)

D_FF = 4 * D_MODEL

EVEN_SPLITS = (SB_WIDTH, 2 * SB_WIDTH, 3 * SB_WIDTH, 3 * SB_WIDTH + CONV_DIM, 3 * SB_WIDTH + 2 * CONV_DIM)
EVEN_IN = 3 * SB_WIDTH + 3 * CONV_DIM
EVEN_MIX = SB_WIDTH + CONV_DIM
ODD_SPLITS = (SGU_DIM, 2 * SGU_DIM, 2 * SGU_DIM + Q_LORA, 2 * SGU_DIM + Q_LORA + KV_LORA)
ODD_IN = 2 * SGU_DIM + Q_LORA + KV_LORA + ROPE_DIM
ODD_MIX = SGU_DIM + MLA_HEADS * V_DIM

kernel_name = "hybrid_streaming_encoder_step"


def rms_norm(x, g):
    xf = x.astype(jnp.float32)
    y = xf * lax.rsqrt(jnp.mean(xf * xf, axis=-1, keepdims=True) + EPS)
    return (y * g.astype(jnp.float32)).astype(x.dtype)


def layer_norm(x, g, b):
    xf = x.astype(jnp.float32)
    mu = jnp.mean(xf, axis=-1, keepdims=True)
    xc = xf - mu
    var = jnp.mean(xc * xc, axis=-1, keepdims=True)
    return (xc * lax.rsqrt(var + EPS) * g.astype(jnp.float32) + b.astype(jnp.float32)).astype(x.dtype)


def rope(x, pos):
    half = ROPE_DIM // 2
    inv = ROPE_THETA ** (-jnp.arange(half, dtype=jnp.float32) / half)
    ang = pos.astype(jnp.float32)[:, None] * inv[None, :]
    shape = (1, ang.shape[0]) + (1,) * (x.ndim - 3) + (half,)
    cos = jnp.cos(ang).reshape(shape)
    sin = jnp.sin(ang).reshape(shape)
    xf = x.astype(jnp.float32)
    x1, x2 = xf[..., :half], xf[..., half:]
    return jnp.concatenate([x1 * cos - x2 * sin, x1 * sin + x2 * cos], axis=-1).astype(x.dtype)


def attend_in_query_blocks(fn, q_arrays, q_pos):
    T = q_pos.shape[0]
    if T <= Q_BLOCK:
        return fn(*q_arrays, q_pos)
    nb = T // Q_BLOCK
    blocks = tuple(jnp.moveaxis(a.reshape((a.shape[0], nb, Q_BLOCK) + a.shape[2:]), 1, 0) for a in q_arrays)
    out = lax.map(lambda args: fn(*args), blocks + (q_pos.reshape(nb, Q_BLOCK),))
    out = jnp.moveaxis(out, 0, 1)
    return out.reshape((out.shape[0], T) + out.shape[3:])


def sb_attend(q, k, v, q_pos, k_pos):
    f32 = jnp.float32
    z = jnp.einsum("bqhd,bkhd->bhqk", q.astype(f32), k.astype(f32)) * SB_SCALE
    visible = k_pos[None, :] < q_pos[:, None]
    log_beta = jax.nn.log_sigmoid(z)
    log_1m_beta = jnp.where(visible, jax.nn.log_sigmoid(-z), 0.0)
    later = lax.cumsum(log_1m_beta, axis=3, reverse=True) - log_1m_beta
    w = jnp.where(visible, jnp.exp(log_beta + later), 0.0)
    return jnp.einsum("bhqk,bkhd->bqhd", w, v.astype(f32)).astype(q.dtype)


def short_conv(u, prev, w):
    ext = jnp.concatenate([prev, u], axis=1)
    y = lax.conv_general_dilated(ext, w[:, None, :].astype(ext.dtype), window_strides=(1,), padding="VALID",
                                 dimension_numbers=("NWC", "WIO", "NWC"), feature_group_count=u.shape[-1])
    return y, ext[:, -(CONV_W - 1):]


def spatial_gate(vn, w_s, b_s):
    B, T, _ = vn.shape
    L = min(T, SGU_CHUNK)
    nc = T // L
    vg = vn.reshape(B, nc, L, SGU_GROUPS, SGU_GROUP_DIM)
    tri = jnp.tril(jnp.ones((L, L), dtype=bool))
    ws = jnp.where(tri, w_s[:, :L, :L], 0.0)
    s = jnp.einsum("gts,bcsgd->bctgd", ws, vg) + jnp.transpose(b_s[:, :L])[None, None, :, :, None]
    return s.reshape(B, T, SGU_DIM)


def mla_attend(q_lat, q_pe, ckv, kpe, q_pos, k_pos):
    f32 = jnp.float32
    ckv32 = ckv.astype(f32)
    s = (jnp.einsum("bqhc,bkc->bhqk", q_lat.astype(f32), ckv32)
         + jnp.einsum("bqhr,bkr->bhqk", q_pe.astype(f32), kpe.astype(f32)))
    visible = (k_pos[None, :] // CHUNK) <= (q_pos[:, None] // CHUNK)
    p = jax.nn.softmax(jnp.where(visible, s * MLA_SCALE, -1e30), axis=-1)
    return jnp.einsum("bhqk,bkc->bqhc", p, ckv32).astype(q_lat.dtype)


def even_mixer(h, pos, past, w_in, w_conv, w_out):
    B, T, _ = h.shape
    q, k, v, g_post, g_pre, u = jnp.split(h @ w_in, EVEN_SPLITS, axis=-1)
    q = q.reshape(B, T, SB_HEADS, SB_HEAD_DIM)
    k = k.reshape(B, T, SB_HEADS, SB_HEAD_DIM)
    v = v.reshape(B, T, SB_HEADS, SB_HEAD_DIM)
    conv_in = g_pre * u
    if past is None:
        k_all, v_all, k_pos = k, v, pos
        conv_prev = jnp.zeros((B, CONV_W - 1, CONV_DIM), conv_in.dtype)
    else:
        k_past, v_past, conv_prev = past
        k_all = jnp.concatenate([k_past, k], axis=1)
        v_all = jnp.concatenate([v_past, v], axis=1)
        k_pos = jnp.concatenate([jnp.arange(k_past.shape[1], dtype=jnp.int32), pos])
    attn = attend_in_query_blocks(lambda qb, pb: sb_attend(qb, k_all, v_all, pb, k_pos), (q,), pos)
    conv_out, conv_state = short_conv(conv_in, conv_prev, w_conv)
    mixed = jnp.concatenate([attn.reshape(B, T, SB_WIDTH), g_post * conv_out], axis=-1)
    return mixed @ w_out, (k, v, conv_state)


def odd_mixer(h, pos, past, w_in, ln_g, ln_b, w_s, b_s, q_norm_g, kv_norm_g, w_uq, w_uk, w_uv, w_out):
    B, T, _ = h.shape
    u, v, cq, ckv, kpe = jnp.split(h @ w_in, ODD_SPLITS, axis=-1)
    vn = layer_norm(v, ln_g, ln_b)
    sgu = u * spatial_gate(vn, w_s, b_s)
    cq = rms_norm(cq, q_norm_g)
    qf = (cq @ w_uq).reshape(B, T, MLA_HEADS, NOPE_DIM + ROPE_DIM)
    q_nope = qf[..., :NOPE_DIM]
    q_pe = rope(qf[..., NOPE_DIM:], pos)
    q_lat = jnp.einsum("bthn,hnc->bthc", q_nope, w_uk)
    ckv = rms_norm(ckv, kv_norm_g)
    kpe = rope(kpe, pos)
    if past is None:
        ckv_all, kpe_all, k_pos = ckv, kpe, pos
    else:
        ckv_past, kpe_past = past
        ckv_all = jnp.concatenate([ckv_past, ckv], axis=1)
        kpe_all = jnp.concatenate([kpe_past, kpe], axis=1)
        k_pos = jnp.concatenate([jnp.arange(ckv_past.shape[1], dtype=jnp.int32), pos])
    o_lat = attend_in_query_blocks(lambda ql, qp, pb: mla_attend(ql, qp, ckv_all, kpe_all, pb, k_pos),
                                   (q_lat, q_pe), pos)
    attn = jnp.einsum("bthc,hcv->bthv", o_lat, w_uv).reshape(B, T, MLA_HEADS * V_DIM)
    out = jnp.concatenate([sgu, attn], axis=-1) @ w_out
    return out, (ckv, kpe, vn)


def sq_relu_mlp(h, w_up, w_down):
    return jnp.square(jax.nn.relu(h @ w_up)) @ w_down


def run_trunk(x, pos, past, p):
    sb_k, sb_v, conv, ckv, kpe, sgu_v = [], [], [], [], [], []
    for layer in range(DEPTH):
        j = layer // 2
        h = rms_norm(x, p["mix_pre_g"][layer])
        if layer % 2 == 0:
            lp = None if past is None else (past["sb_k"][j], past["sb_v"][j], past["conv"][j])
            out, (k_new, v_new, c_new) = even_mixer(h, pos, lp, p["even_w_in"][j], p["even_w_conv"][j],
                                                    p["even_w_out"][j])
            sb_k.append(k_new)
            sb_v.append(v_new)
            conv.append(c_new)
        else:
            lp = None if past is None else (past["ckv"][j], past["kpe"][j])
            out, (ckv_new, kpe_new, vn) = odd_mixer(
                h, pos, lp, p["odd_w_in"][j], p["sgu_ln_g"][j], p["sgu_ln_b"][j], p["sgu_w_s"][j],
                p["sgu_b_s"][j], p["mla_q_norm_g"][j], p["mla_kv_norm_g"][j], p["mla_w_uq"][j],
                p["mla_w_uk"][j], p["mla_w_uv"][j], p["odd_w_out"][j])
            ckv.append(ckv_new)
            kpe.append(kpe_new)
            if past is not None:
                sgu_v.append(vn)
        x = x + rms_norm(out, p["mix_post_g"][layer])
        h = rms_norm(x, p["ffn_pre_g"][layer])
        x = x + rms_norm(sq_relu_mlp(h, p["ffn_w_up"][layer], p["ffn_w_down"][layer]), p["ffn_post_g"][layer])
    states = {"sb_k": jnp.stack(sb_k), "sb_v": jnp.stack(sb_v), "conv": jnp.stack(conv),
              "ckv": jnp.stack(ckv), "kpe": jnp.stack(kpe)}
    if past is not None:
        states["sgu_v"] = jnp.stack(sgu_v)
    return x, states


def _normal(k, shape, scale):
    return scale * jax.random.normal(k, shape, jnp.float32)


def _gain(k, shape):
    return 1.0 + 0.05 * jax.random.normal(k, shape, jnp.float32)


def setup_inputs(seed: int = 0) -> dict:
    key = jax.random.key(seed)
    ks = jax.random.split(key, 27)
    return {
        "x_prompt": _normal(ks[0], (BATCH, SEQ, D_MODEL), 1.0),
        "x_sample": _normal(ks[1], (DEC_BATCH, DEC_SEQ, D_MODEL), 1.0),
        "cache_sb_k": _normal(ks[2], (N_EVEN, DEC_BATCH, PAST_LEN, SB_HEADS, SB_HEAD_DIM), 1.0),
        "cache_sb_v": _normal(ks[3], (N_EVEN, DEC_BATCH, PAST_LEN, SB_HEADS, SB_HEAD_DIM), 1.0),
        "state_conv": _normal(ks[4], (N_EVEN, DEC_BATCH, CONV_W - 1, CONV_DIM), 1.0),
        "cache_mla_ckv": _normal(ks[5], (N_ODD, DEC_BATCH, PAST_LEN, KV_LORA), 1.0),
        "cache_mla_kpe": _normal(ks[6], (N_ODD, DEC_BATCH, PAST_LEN, ROPE_DIM), 1.0),
        "mix_pre_g": _gain(ks[7], (DEPTH, D_MODEL)),
        "mix_post_g": _gain(ks[8], (DEPTH, D_MODEL)),
        "ffn_pre_g": _gain(ks[9], (DEPTH, D_MODEL)),
        "ffn_post_g": _gain(ks[10], (DEPTH, D_MODEL)),
        "even_w_in": _normal(ks[11], (N_EVEN, D_MODEL, EVEN_IN), D_MODEL ** -0.5),
        "even_w_conv": _normal(ks[12], (N_EVEN, CONV_W, CONV_DIM), CONV_W ** -0.5),
        "even_w_out": _normal(ks[13], (N_EVEN, EVEN_MIX, D_MODEL), EVEN_MIX ** -0.5),
        "odd_w_in": _normal(ks[14], (N_ODD, D_MODEL, ODD_IN), D_MODEL ** -0.5),
        "sgu_ln_g": _gain(ks[15], (N_ODD, SGU_DIM)),
        "sgu_ln_b": _normal(ks[16], (N_ODD, SGU_DIM), 0.02),
        "sgu_w_s": _normal(ks[17], (N_ODD, SGU_GROUPS, SGU_CHUNK, SGU_CHUNK), SGU_CHUNK ** -0.5),
        "sgu_b_s": _gain(ks[18], (N_ODD, SGU_GROUPS, SGU_CHUNK)),
        "mla_q_norm_g": _gain(ks[19], (N_ODD, Q_LORA)),
        "mla_kv_norm_g": _gain(ks[20], (N_ODD, KV_LORA)),
        "mla_w_uq": _normal(ks[21], (N_ODD, Q_LORA, MLA_HEADS * (NOPE_DIM + ROPE_DIM)), Q_LORA ** -0.5),
        "mla_w_uk": _normal(ks[22], (N_ODD, MLA_HEADS, NOPE_DIM, KV_LORA), KV_LORA ** -0.5),
        "mla_w_uv": _normal(ks[23], (N_ODD, MLA_HEADS, KV_LORA, V_DIM), KV_LORA ** -0.5),
        "odd_w_out": _normal(ks[24], (N_ODD, ODD_MIX, D_MODEL), ODD_MIX ** -0.5),
        "ffn_w_up": _normal(ks[25], (DEPTH, D_MODEL, D_FF), D_MODEL ** -0.5),
        "ffn_w_down": _normal(ks[26], (DEPTH, D_FF, D_MODEL), D_FF ** -0.5),
    }


def reference(x_prompt, x_sample, cache_sb_k, cache_sb_v, state_conv, cache_mla_ckv, cache_mla_kpe,
              mix_pre_g, mix_post_g, ffn_pre_g, ffn_post_g, even_w_in, even_w_conv, even_w_out,
              odd_w_in, sgu_ln_g, sgu_ln_b, sgu_w_s, sgu_b_s, mla_q_norm_g, mla_kv_norm_g,
              mla_w_uq, mla_w_uk, mla_w_uv, odd_w_out, ffn_w_up, ffn_w_down):
    params = {
        "mix_pre_g": mix_pre_g, "mix_post_g": mix_post_g, "ffn_pre_g": ffn_pre_g, "ffn_post_g": ffn_post_g,
        "even_w_in": even_w_in, "even_w_conv": even_w_conv, "even_w_out": even_w_out,
        "odd_w_in": odd_w_in, "sgu_ln_g": sgu_ln_g, "sgu_ln_b": sgu_ln_b, "sgu_w_s": sgu_w_s,
        "sgu_b_s": sgu_b_s, "mla_q_norm_g": mla_q_norm_g, "mla_kv_norm_g": mla_kv_norm_g,
        "mla_w_uq": mla_w_uq, "mla_w_uk": mla_w_uk, "mla_w_uv": mla_w_uv, "odd_w_out": odd_w_out,
        "ffn_w_up": ffn_w_up, "ffn_w_down": ffn_w_down,
    }
    pos_p = jnp.arange(x_prompt.shape[1], dtype=jnp.int32)
    y_prompt, st_p = run_trunk(x_prompt, pos_p, None, params)
    past_len = cache_sb_k.shape[2]
    pos_s = past_len + jnp.arange(x_sample.shape[1], dtype=jnp.int32)
    past = {"sb_k": cache_sb_k, "sb_v": cache_sb_v, "conv": state_conv,
            "ckv": cache_mla_ckv, "kpe": cache_mla_kpe}
    y_sample, st_s = run_trunk(x_sample, pos_s, past, params)
    return (y_prompt, y_sample,
            st_p["sb_k"], st_p["sb_v"], st_p["conv"], st_p["ckv"], st_p["kpe"],
            st_s["sb_k"], st_s["sb_v"], st_s["conv"], st_s["ckv"], st_s["kpe"], st_s["sgu_v"])
```

```cpp
#include <hip/hip_runtime.h>
#include <hip/hip_cooperative_groups.h>
#include <cstdio>
#include <cstdint>
namespace cg = cooperative_groups;

#define DEVI __device__ __forceinline__
typedef unsigned short bf16_t;
typedef short bf16x8 __attribute__((ext_vector_type(8)));
typedef short s4v __attribute__((ext_vector_type(4)));
typedef float f32x4 __attribute__((ext_vector_type(4)));
typedef float f32x16 __attribute__((ext_vector_type(16)));
typedef unsigned u32x4 __attribute__((ext_vector_type(4)));
typedef unsigned u32x2 __attribute__((ext_vector_type(2)));

constexpr int NP = 65536;
constexpr int NS = 512;
constexpr int MT = NP + NS;
constexpr float EPS = 1e-6f;
constexpr float LOG2E = 1.4426950408889634f;
constexpr float SBQ = 0.125f * LOG2E;
constexpr float MLQ = 0.10206207261596577f * LOG2E;

constexpr size_t O_Y = 0;
constexpr size_t O_SBK_P = (size_t)MT * 1024;
constexpr size_t O_SBV_P = O_SBK_P + (size_t)NP * 512;
constexpr size_t O_CONV_P = O_SBV_P + (size_t)NP * 512;
constexpr size_t O_CKV_P = O_CONV_P + 32 * 2 * 512;
constexpr size_t O_KPE_P = O_CKV_P + (size_t)NP * 256;
constexpr size_t O_SBK_S = O_KPE_P + (size_t)NP * 32;
constexpr size_t O_SBV_S = O_SBK_S + (size_t)NS * 512;
constexpr size_t O_CONV_S = O_SBV_S + (size_t)NS * 512;
constexpr size_t O_CKV_S = O_CONV_S + 32 * 2 * 512;
constexpr size_t O_KPE_S = O_CKV_S + (size_t)NS * 256;
constexpr size_t O_SGUV_S = O_KPE_S + (size_t)NS * 32;

constexpr size_t WS_CTR = 0;
constexpr size_t WS_W1T = 16384;
constexpr size_t WS_WO1T = WS_W1T + 3072ull * 1024 * 2;
constexpr size_t WS_WUP0 = WS_WO1T + 1024ull * 1024 * 2;
constexpr size_t WS_WDN0 = WS_WUP0 + 4096ull * 1024 * 2;
constexpr size_t WS_WUP1 = WS_WDN0 + 4096ull * 1024 * 2;
constexpr size_t WS_WDN1 = WS_WUP1 + 4096ull * 1024 * 2;
constexpr size_t WS_W2T = WS_WDN1 + 4096ull * 1024 * 2;
constexpr size_t WS_WUQT = WS_W2T + 1792ull * 1024 * 2;
constexpr size_t WS_WKVT = WS_WUQT + 768ull * 384 * 2;
constexpr size_t WS_WQLT = WS_WKVT + 1024ull * 256 * 2;
constexpr size_t WS_WO2T = WS_WQLT + 2048ull * 384 * 2;
constexpr size_t WS_H = WS_WO2T + 1024ull * 1024 * 2;
constexpr size_t WS_O = WS_H + (size_t)MT * 1024 * 2;
constexpr size_t WS_KC = WS_O + (size_t)MT * 1024 * 2;
constexpr size_t WS_R1 = WS_KC + 32ull * 4112 * 288 * 2;
constexpr size_t R1_QKVG = 0;
constexpr size_t R1_MIXED = (size_t)MT * 3072 * 2;
constexpr size_t R1_ACT = 0;
constexpr size_t R1_IN1 = 0;
constexpr size_t R1_QF = (size_t)MT * 1792 * 2;
constexpr size_t R1_KVUP = R1_QF + (size_t)MT * 768 * 2;
constexpr size_t R1_QLAT = R1_KVUP + (size_t)MT * 1024 * 2;
constexpr size_t R1_MIXED2 = R1_QLAT + 512ull * 2048 * 2;
constexpr size_t WS_RS = WS_R1 + R1_MIXED2 + (size_t)MT * 1024 * 2;
constexpr size_t WS_END = WS_RS + (size_t)MT * 4;

struct Params {
    const float* in[27];
    float* out;
    unsigned char* ws;
};

typedef __bf16 bf2v __attribute__((ext_vector_type(2)));
DEVI unsigned short f2bf(float f) { __bf16 v = (__bf16)f; return __builtin_bit_cast(unsigned short, v); }
DEVI unsigned pk2(float a, float b) { bf2v v = {(__bf16)a, (__bf16)b}; return __builtin_bit_cast(unsigned, v); }
DEVI float bflo(unsigned w) { return __uint_as_float(w << 16); }
DEVI float bfhi(unsigned w) { return __uint_as_float(w & 0xffff0000u); }
DEVI float bf2f(unsigned short h) { return __uint_as_float(((unsigned)h) << 16); }
DEVI float wave_sum(float v) {
#pragma unroll
    for (int o = 32; o > 0; o >>= 1) v += __shfl_xor(v, o);
    return v;
}
DEVI void unpack8(u32x4 w, float* f) {
    f[0] = bflo(w.x); f[1] = bfhi(w.x); f[2] = bflo(w.y); f[3] = bfhi(w.y);
    f[4] = bflo(w.z); f[5] = bfhi(w.z); f[6] = bflo(w.w); f[7] = bfhi(w.w);
}
DEVI u32x4 pack8(const float* f) { u32x4 w; w.x = pk2(f[0], f[1]); w.y = pk2(f[2], f[3]); w.z = pk2(f[4], f[5]); w.w = pk2(f[6], f[7]); return w; }
DEVI int get_tid() { int t = threadIdx.x; asm volatile("" : "+v"(t)); return t; }
DEVI int row_pos(int row) { return row < NP ? (row & 2047) : 4096 + ((row - NP) & 15); }

constexpr int BM = 256, BK = 64, HALF = 128, HT = HALF * BK;
DEVI int lds_byte(int r, int c) {
    int st = (r >> 4) * 2 + (c >> 5), rr = r & 15, cc = c & 31, ob = rr * 64 + cc * 2;
    return st * 1024 + (ob ^ (((ob >> 9) & 1) << 5));
}
DEVI void stage_rc(int b, int& R, int& C) {
    int st = b / 1024, sb = b % 1024, swz = sb ^ (((sb >> 9) & 1) << 5);
    R = (st >> 1) * 16 + swz / 64; C = (st & 1) * 32 + (swz % 64) / 2;
}

#define LAS __attribute__((address_space(3)))
template <int NSTORE, class TF, class F>
DEVI void gemm_run(const bf16_t* __restrict__ A, int lda, const bf16_t* __restrict__ Bt, int ldb, int K, bf16_t* shm, TF&& tile, F&& emit) {
    LAS unsigned char* lds = (LAS unsigned char*)shm;
    const int tid = get_tid(), wid = __builtin_amdgcn_readfirstlane(tid >> 6), lane = tid & 63, wr = wid >> 2, wc = wid & 3, fr = lane & 15, fq = lane >> 4;
    const int nt = K / BK;
    unsigned voffA[2], voffB[2];
#pragma unroll
    for (int i = 0; i < 2; ++i) { int R, C; stage_rc(tid * 16 + i * 8192, R, C); const int rho = R & 31; const int Rb = (R & ~31) + (8 * ((rho & 15) >> 2) + 4 * (rho >> 4) + (rho & 3));
        voffA[i] = (unsigned)(R * lda + C) * 2u; voffB[i] = (unsigned)(Rb * ldb + C) * 2u; }
    const size_t kstep = (size_t)(BK * 2);
    const size_t hstepA = (size_t)HALF * lda * 2, hstepB = (size_t)HALF * ldb * 2;
    const unsigned ldsw = (unsigned)wid * 1024u;
    const int aoff = lds_byte(wr * 64 + fr, fq * 8), boff = lds_byte(wc * 32 + fr, fq * 8);
    constexpr int HTB = HALF * BK * 2;
#define G_SA(b, h) (((b) * 2 + (h)) * HTB)
#define G_SB(b, h) ((4 + (b) * 2 + (h)) * HTB)
#define G_STAGE(bufoff, gbase, voff) do { _Pragma("unroll") for (int _i = 0; _i < 2; ++_i) \
        __builtin_amdgcn_global_load_lds((const unsigned*)((const char*)(gbase) + (voff)[_i]), (LAS unsigned*)(lds + (bufoff) + ldsw + _i * 8192), 16, 0, 0); } while (0)
#define G_LDA(dst, b, h) do { _Pragma("unroll") for (int m = 0; m < 4; ++m) _Pragma("unroll") for (int k = 0; k < 2; ++k) dst[m][k] = *(const LAS bf16x8*)(lds + G_SA(b, h) + aoff + m * 2048 + k * 1024); } while (0)
#define G_LDB(dst, b, h) do { _Pragma("unroll") for (int n = 0; n < 2; ++n) _Pragma("unroll") for (int k = 0; k < 2; ++k) dst[n][k] = *(const LAS bf16x8*)(lds + G_SB(b, h) + boff + n * 2048 + k * 1024); } while (0)
#define G_MMA(ai, bj, At, Bt_) do { __builtin_amdgcn_s_setprio(1); _Pragma("unroll") for (int m = 0; m < 4; ++m) _Pragma("unroll") for (int n = 0; n < 2; ++n) _Pragma("unroll") for (int k = 0; k < 2; ++k) \
        acc[ai][bj][m][n] = __builtin_amdgcn_mfma_f32_16x16x32_bf16(Bt_[n][k], At[m][k], acc[ai][bj][m][n], 0, 0, 0); __builtin_amdgcn_s_setprio(0); } while (0)
#define G_WAIT_V(n) asm volatile("s_waitcnt vmcnt(" #n ")" ::: "memory")
#define G_WAIT_L(n) asm volatile("s_waitcnt lgkmcnt(" #n ")" ::: "memory")
#define G_BAR __builtin_amdgcn_s_barrier()
#define G_SCHED __builtin_amdgcn_sched_barrier(0)
    int brow, bcol, nrow, ncol; int ui = 0;
    if (!tile(0, brow, bcol)) return;
    f32x4 acc[2][2][4][2];
#pragma unroll
    for (int a = 0; a < 2; ++a)
#pragma unroll
        for (int b = 0; b < 2; ++b)
#pragma unroll
            for (int m = 0; m < 4; ++m)
#pragma unroll
                for (int n = 0; n < 2; ++n) acc[a][b][m][n] = (f32x4){0.f, 0.f, 0.f, 0.f};
    bf16x8 At[4][2], B0[2][2], B1[2][2];
    const char* cA = (const char*)A + (size_t)brow * lda * 2; const char* cB = (const char*)Bt + (size_t)bcol * ldb * 2;
    G_STAGE(G_SB(0, 0), cB, voffB); G_STAGE(G_SB(0, 1), cB + hstepB, voffB); G_STAGE(G_SA(0, 0), cA, voffA); G_STAGE(G_SA(0, 1), cA + hstepA, voffA);
    if (wr == 1) G_BAR;
    G_WAIT_V(2); G_BAR;
    G_STAGE(G_SB(1, 0), cB + kstep, voffB); G_STAGE(G_SA(1, 0), cA + kstep, voffA); G_STAGE(G_SB(1, 1), cB + hstepB + kstep, voffB);
    G_WAIT_V(6); G_BAR;
    for (;;) {
        const bool has_next = tile(ui + 1, nrow, ncol);
        const char* nA = has_next ? (const char*)A + (size_t)nrow * lda * 2 : cA; const char* nB = has_next ? (const char*)Bt + (size_t)ncol * ldb * 2 : cB;
        for (int t = 0; t < nt; t += 2) {
            const bool last = (t == nt - 2);
            const char* a1 = cA + (size_t)(t + 1) * kstep;
            const char* a2 = last ? nA : cA + (size_t)(t + 2) * kstep; const char* b2 = last ? nB : cB + (size_t)(t + 2) * kstep;
            const char* a3 = a2 + kstep; const char* b3 = b2 + kstep;
            G_LDB(B0, 0, 0); G_LDB(B1, 0, 1); G_SCHED; G_LDA(At, 0, 0); G_STAGE(G_SA(1, 1), a1 + hstepA, voffA);
            G_WAIT_V(8); G_WAIT_L(0); G_BAR; G_MMA(0, 0, At, B0); G_MMA(0, 1, At, B1); G_BAR; G_SCHED;
            G_LDA(At, 0, 1); G_STAGE(G_SB(0, 0), b2, voffB); G_STAGE(G_SB(0, 1), b2 + hstepB, voffB); G_STAGE(G_SA(0, 0), a2, voffA);
            G_WAIT_V(8); G_WAIT_L(0); G_BAR; G_MMA(1, 0, At, B0); G_MMA(1, 1, At, B1); G_BAR; G_SCHED;
            G_LDB(B0, 1, 0); G_LDB(B1, 1, 1); G_SCHED; G_LDA(At, 1, 0); G_STAGE(G_SA(0, 1), a2 + hstepA, voffA);
            G_WAIT_V(8); G_WAIT_L(0); G_BAR; G_MMA(0, 0, At, B0); G_MMA(0, 1, At, B1); G_BAR; G_SCHED;
            G_LDA(At, 1, 1); G_STAGE(G_SB(1, 0), b3, voffB); G_STAGE(G_SB(1, 1), b3 + hstepB, voffB); G_STAGE(G_SA(1, 0), a3, voffA);
            G_WAIT_V(8); G_WAIT_L(0); G_BAR; G_MMA(1, 0, At, B0); G_MMA(1, 1, At, B1); G_BAR; G_SCHED;
        }
        if (NSTORE != 0 && wr == 0) G_BAR;
#pragma unroll
        for (int ai = 0; ai < 2; ++ai)
#pragma unroll
            for (int m = 0; m < 4; ++m)
#pragma unroll
                for (int bj = 0; bj < 2; ++bj)
                    emit(brow + ai * HALF + wr * 64 + m * 16 + fr, bcol + bj * HALF + wc * 32 + fq * 8, acc[ai][bj][m][0], acc[ai][bj][m][1]);
        if (!has_next) break;
#pragma unroll
        for (int a = 0; a < 2; ++a)
#pragma unroll
            for (int b = 0; b < 2; ++b)
#pragma unroll
                for (int m = 0; m < 4; ++m)
#pragma unroll
                    for (int n = 0; n < 2; ++n) acc[a][b][m][n] = (f32x4){0.f, 0.f, 0.f, 0.f};
        brow = nrow; bcol = ncol; cA = nA; cB = nB; ++ui;
        if (NSTORE != 0 && wr == 1) G_BAR;
    }
    G_WAIT_V(0);
    if (NSTORE == 0 && wr == 0) G_BAR;
    G_BAR;
#undef G_SA
#undef G_SB
#undef G_STAGE
#undef G_LDA
#undef G_LDB
#undef G_MMA
}

DEVI void tile_map(int L, int nM, int nN, int& pm, int& pn) {
    const int nwg = nM * nN;
    int wgid = L;
    { const int q = nwg / 8, r = nwg % 8, xcd = wgid % 8, off = wgid / 8; wgid = (xcd < r ? xcd * (q + 1) : r * (q + 1) + (xcd - r) * q) + off; }
    const int nig = 8 * nN, gid = wgid / nig, fm = gid * 8, gsz = (nM - fm) < 8 ? (nM - fm) : 8;
    pm = fm + ((wgid % nig) % gsz); pn = (wgid % nig) / gsz;
}

template <int KW, class F>
DEVI void gemm_small(const bf16_t* __restrict__ A, int lda, const bf16_t* __restrict__ Bt, int ldb, int K, int row0, int col0, float* lds, F&& emit) {
    constexpr int RW = 8 / KW, MT16 = 4 / RW;
    const int tid = get_tid(), wv = tid >> 6, lane = tid & 63, fr = lane & 15, fq = lane >> 4;
    const int kq = wv % KW, rh = wv / KW;
    const int ks = K / KW, kbeg = kq * ks;
    f32x4 acc[MT16][4];
#pragma unroll
    for (int m = 0; m < MT16; ++m)
#pragma unroll
        for (int n = 0; n < 4; ++n) acc[m][n] = (f32x4){0.f, 0.f, 0.f, 0.f};
    const bf16_t* ap = A + (size_t)(row0 + rh * (64 / RW) + fr) * lda + kbeg + 8 * fq;
    const bf16_t* bp = Bt + (size_t)(col0 + 8 * (fr >> 2) + (fr & 3)) * ldb + kbeg + 8 * fq;
#pragma unroll 4
    for (int k = 0; k < ks; k += 32) {
        bf16x8 af[MT16], bfr[4];
#pragma unroll
        for (int m = 0; m < MT16; ++m) af[m] = *(const bf16x8*)(ap + (size_t)(m * 16) * lda + k);
#pragma unroll
        for (int n = 0; n < 4; ++n) bfr[n] = *(const bf16x8*)(bp + (size_t)((n >> 1) * 32 + (n & 1) * 4) * ldb + k);
#pragma unroll
        for (int m = 0; m < MT16; ++m)
#pragma unroll
            for (int n = 0; n < 4; ++n) acc[m][n] = __builtin_amdgcn_mfma_f32_16x16x32_bf16(bfr[n], af[m], acc[m][n], 0, 0, 0);
    }
    __syncthreads();
    float* slab = lds + kq * 4096;
#pragma unroll
    for (int m = 0; m < MT16; ++m)
#pragma unroll
        for (int n = 0; n < 4; ++n) {
            const int row = rh * (64 / RW) + m * 16 + fr, grp = ((n >> 1) * 8 + 2 * fq + (n & 1)) ^ (row & 15);
            *(f32x4*)(slab + row * 64 + grp * 4) = acc[m][n];
        }
    __syncthreads();
    {
        const int row = tid >> 3, c = tid & 7, g0 = c * 2, g1 = g0 + 1;
        f32x4 v0 = {0.f, 0.f, 0.f, 0.f}, v1 = {0.f, 0.f, 0.f, 0.f};
#pragma unroll
        for (int w = 0; w < KW; ++w) {
            v0 += *(const f32x4*)(lds + w * 4096 + row * 64 + ((g0 ^ (row & 15)) * 4));
            v1 += *(const f32x4*)(lds + w * 4096 + row * 64 + ((g1 ^ (row & 15)) * 4));
        }
        emit(row0 + row, col0 + g0 * 4, v0, v1);
    }
    __syncthreads();
}

DEVI void st_bf16x8(bf16_t* p, f32x4 a, f32x4 b) { u32x4 w; w.x = pk2(a[0], a[1]); w.y = pk2(a[2], a[3]); w.z = pk2(b[0], b[1]); w.w = pk2(b[2], b[3]); *(u32x4*)p = w; }

struct TJob { const float* src; bf16_t* dst; int K, N, Npad, src_ld; float scale; int scale_cols; const float* kgain; };
DEVI bool get_tjob(const Params& p, int j, TJob& t) {
    unsigned char* ws = p.ws;
    switch (j) {
    case 0: t = {p.in[11], (bf16_t*)(ws + WS_W1T), 1024, 3072, 3072, 3072, SBQ, 512, p.in[7]}; return true;
    case 1: t = {p.in[13], (bf16_t*)(ws + WS_WO1T), 1024, 1024, 1024, 1024, 1.f, 0, nullptr}; return true;
    case 2: t = {p.in[25], (bf16_t*)(ws + WS_WUP0), 1024, 4096, 4096, 4096, 1.f, 0, p.in[9]}; return true;
    case 3: t = {p.in[25] + 1024ull * 4096, (bf16_t*)(ws + WS_WUP1), 1024, 4096, 4096, 4096, 1.f, 0, p.in[9] + 1024}; return true;
    case 4: t = {p.in[26], (bf16_t*)(ws + WS_WDN0), 4096, 1024, 1024, 1024, 1.f, 0, nullptr}; return true;
    case 5: t = {p.in[26] + 1024ull * 4096, (bf16_t*)(ws + WS_WDN1), 4096, 1024, 1024, 1024, 1.f, 0, nullptr}; return true;
    case 6: t = {p.in[14], (bf16_t*)(ws + WS_W2T), 1024, 1696, 1792, 1696, 1.f, 0, p.in[7] + 1024}; return true;
    case 7: t = {p.in[21], (bf16_t*)(ws + WS_WUQT), 384, 768, 768, 768, MLQ, 768, nullptr}; return true;
    case 8: t = {p.in[24], (bf16_t*)(ws + WS_WO2T), 1024, 1024, 1024, 1024, 1.f, 0, nullptr}; return true;
    default:
        if (j < 17) { int h = j - 9; t = {p.in[23] + (size_t)h * 256 * 64, (bf16_t*)(ws + WS_WKVT) + (size_t)(512 + h * 64) * 256, 256, 64, 64, 64, 1.f, 0, nullptr}; return true; }
        return false;
    }
}

DEVI void phase_prep(const Params& p, float* lds) {
    const int tid = get_tid();
    int base = 0;
    for (int j = 0; j < 17; ++j) {
        TJob t; get_tjob(p, j, t);
        const int tk = t.K / 64, tn = t.Npad / 64, ntile = tk * tn;
        int first = ((int)blockIdx.x - base % (int)gridDim.x + (int)gridDim.x) % (int)gridDim.x;
        for (int i = first; i < ntile; i += gridDim.x) {
            const int k0 = (i % tk) * 64, n0 = (i / tk) * 64;
            __syncthreads();
#pragma unroll
            for (int e = 0; e < 2; ++e) {
                const int idx = tid + e * 512, kk = idx >> 4, n4 = (idx & 15) * 4, n = n0 + n4;
                f32x4 v = {0.f, 0.f, 0.f, 0.f};
                if (n < t.N) { v = *(const f32x4*)(t.src + (size_t)(k0 + kk) * t.src_ld + n); if (n < t.scale_cols) v = v * t.scale; if (t.kgain) v = v * t.kgain[k0 + kk]; }
                lds[kk * 65 + n4] = v[0]; lds[kk * 65 + n4 + 1] = v[1]; lds[kk * 65 + n4 + 2] = v[2]; lds[kk * 65 + n4 + 3] = v[3];
            }
            __syncthreads();
            {
                const int nn = tid >> 3, kc = tid & 7;
                float o[8];
#pragma unroll
                for (int j = 0; j < 8; ++j) o[j] = lds[(kc * 8 + j) * 65 + nn];
                *(u32x4*)(t.dst + (size_t)(n0 + nn) * t.K + k0 + kc * 8) = pack8(o);
            }
        }
        base += ntile;
    }
    const int gtid = blockIdx.x * 512 + tid, gsz = gridDim.x * 512;
    {
        bf16_t* dst = (bf16_t*)(p.ws + WS_WKVT);
        const float* src = p.in[22];
        for (int i = gtid; i < 512 * 256; i += gsz) dst[i] = f2bf(src[i]);
    }
    {
        bf16_t* dst = (bf16_t*)(p.ws + WS_WQLT);
        const float* wuq = p.in[21];
        const float* wuk = p.in[22];
        for (int i = gtid; i < 2048 * 384; i += gsz) {
            int c = i & 255, h = (i >> 8) & 7, j = i >> 11;
            const float* a = wuq + (size_t)j * 768 + h * 96;
            const float* b = wuk + (size_t)h * 64 * 256 + c;
            float s = 0.f;
#pragma unroll 8
            for (int n = 0; n < 64; ++n) s += a[n] * b[(size_t)n * 256];
            dst[(size_t)(h * 256 + c) * 384 + j] = f2bf(s * MLQ);
        }
    }
    {
        const int wv = tid >> 6, lane = tid & 63;
        bf16_t* X = (bf16_t*)(p.ws + WS_H);
        float* RS = (float*)(p.ws + WS_RS);
        for (int rowb = (blockIdx.x * 8 + wv) * 2; rowb < MT; rowb += gridDim.x * 16) {
            float v[2][16]; float ss[2] = {0.f, 0.f};
#pragma unroll
            for (int rr = 0; rr < 2; ++rr) {
                const int row = rowb + rr;
                const float* x = row < NP ? p.in[0] + (size_t)row * 1024 : p.in[1] + (size_t)(row - NP) * 1024;
#pragma unroll
                for (int i = 0; i < 2; ++i) {
                    f32x4 a = *(const f32x4*)(x + i * 512 + lane * 8), b = *(const f32x4*)(x + i * 512 + lane * 8 + 4);
#pragma unroll
                    for (int k = 0; k < 4; ++k) { v[rr][i * 8 + k] = a[k]; v[rr][i * 8 + 4 + k] = b[k]; }
                }
            }
#pragma unroll
            for (int rr = 0; rr < 2; ++rr)
#pragma unroll
                for (int k = 0; k < 16; ++k) ss[rr] += v[rr][k] * v[rr][k];
#pragma unroll
            for (int of = 32; of > 0; of >>= 1) { ss[0] += __shfl_xor(ss[0], of); ss[1] += __shfl_xor(ss[1], of); }
#pragma unroll
            for (int rr = 0; rr < 2; ++rr) {
                const float r = rsqrtf(ss[rr] * (1.f / 1024.f) + EPS);
#pragma unroll
                for (int k = 0; k < 16; ++k) v[rr][k] *= r;
#pragma unroll
                for (int i = 0; i < 2; ++i) *(u32x4*)(X + (size_t)(rowb + rr) * 1024 + i * 512 + lane * 8) = pack8(v[rr] + i * 8);
                if (lane == 0) RS[rowb + rr] = r;
            }
        }
    }
}

DEVI void phase_rowpass(const Params& p, bool first, const float* g1, bool final_) {
    const int tid = get_tid(), wv = tid >> 6, lane = tid & 63;
    const bf16_t* O = (const bf16_t*)(p.ws + WS_O);
    bf16_t* X = (bf16_t*)(p.ws + WS_H);
    float* RS = (float*)(p.ws + WS_RS);
    float ga[16];
#pragma unroll
    for (int i = 0; i < 2; ++i)
#pragma unroll
        for (int k = 0; k < 8; ++k) ga[i * 8 + k] = g1[i * 512 + lane * 8 + k];
    for (int rowb = (blockIdx.x * 8 + wv) * 2; rowb < MT; rowb += gridDim.x * 16) {
        float o[2][16], x[2][16];
#pragma unroll
        for (int rr = 0; rr < 2; ++rr) {
            const int row = rowb + rr;
#pragma unroll
            for (int i = 0; i < 2; ++i) {
                unpack8(*(const u32x4*)(O + (size_t)row * 1024 + i * 512 + lane * 8), o[rr] + i * 8);
                if (first) {
                    const float* xin = row < NP ? p.in[0] + (size_t)row * 1024 : p.in[1] + (size_t)(row - NP) * 1024;
                    f32x4 a = *(const f32x4*)(xin + i * 512 + lane * 8), b = *(const f32x4*)(xin + i * 512 + lane * 8 + 4);
#pragma unroll
                    for (int k = 0; k < 4; ++k) { x[rr][i * 8 + k] = a[k]; x[rr][i * 8 + 4 + k] = b[k]; }
                } else unpack8(*(const u32x4*)(X + (size_t)row * 1024 + i * 512 + lane * 8), x[rr] + i * 8);
            }
            if (!first) {
                const float inv = 1.f / RS[row];
#pragma unroll
                for (int k = 0; k < 16; ++k) x[rr][k] *= inv;
            }
        }
        float ss[2] = {0.f, 0.f};
#pragma unroll
        for (int rr = 0; rr < 2; ++rr)
#pragma unroll
            for (int k = 0; k < 16; ++k) ss[rr] += o[rr][k] * o[rr][k];
#pragma unroll
        for (int of = 32; of > 0; of >>= 1) { ss[0] += __shfl_xor(ss[0], of); ss[1] += __shfl_xor(ss[1], of); }
        float s2[2] = {0.f, 0.f};
#pragma unroll
        for (int rr = 0; rr < 2; ++rr) {
            const float r = rsqrtf(ss[rr] * (1.f / 1024.f) + EPS);
#pragma unroll
            for (int k = 0; k < 16; ++k) { float v = x[rr][k] + o[rr][k] * r * ga[k]; x[rr][k] = v; s2[rr] += v * v; }
        }
        if (final_) {
#pragma unroll
            for (int rr = 0; rr < 2; ++rr) {
                float* y = p.out + O_Y + (size_t)(rowb + rr) * 1024;
#pragma unroll
                for (int i = 0; i < 2; ++i) {
                    *(f32x4*)(y + i * 512 + lane * 8) = (f32x4){x[rr][i * 8], x[rr][i * 8 + 1], x[rr][i * 8 + 2], x[rr][i * 8 + 3]};
                    *(f32x4*)(y + i * 512 + lane * 8 + 4) = (f32x4){x[rr][i * 8 + 4], x[rr][i * 8 + 5], x[rr][i * 8 + 6], x[rr][i * 8 + 7]};
                }
            }
        } else {
#pragma unroll
            for (int of = 32; of > 0; of >>= 1) { s2[0] += __shfl_xor(s2[0], of); s2[1] += __shfl_xor(s2[1], of); }
#pragma unroll
            for (int rr = 0; rr < 2; ++rr) {
                const float r2 = rsqrtf(s2[rr] * (1.f / 1024.f) + EPS);
#pragma unroll
                for (int k = 0; k < 16; ++k) x[rr][k] *= r2;
#pragma unroll
                for (int i = 0; i < 2; ++i) *(u32x4*)(X + (size_t)(rowb + rr) * 1024 + i * 512 + lane * 8) = pack8(x[rr] + i * 8);
                if (lane == 0) RS[rowb + rr] = r2;
            }
        }
    }
}

DEVI void rope_consts(int i, float& crev) { crev = __builtin_amdgcn_exp2f(-(float)i * (13.287712379549449f / 16.f)) * 0.15915494309189535f; }
DEVI void rope_sc(int pos, float crev, float& s, float& c) { float rev = (float)pos * crev; rev -= floorf(rev); s = __builtin_amdgcn_sinf(rev); c = __builtin_amdgcn_cosf(rev); }

DEVI void phase_l1rows(const Params& p) {
    const int tid = get_tid(), wv = tid >> 6, lane = tid & 63;
    bf16_t* IN1 = (bf16_t*)(p.ws + WS_R1 + R1_IN1);
    bf16_t* KC = (bf16_t*)(p.ws + WS_KC);
    const float* lng = p.in[15]; const float* lnb = p.in[16]; const float* qg = p.in[19]; const float* kvg = p.in[20];
    float crev; rope_consts(lane & 15, crev);
    float glng[8], glnb[8], gq[8], gkv[8];
#pragma unroll
    for (int k = 0; k < 8; ++k) { glng[k] = lng[lane * 8 + k]; glnb[k] = lnb[lane * 8 + k]; gq[k] = lane < 48 ? qg[lane * 8 + k] : 0.f; gkv[k] = lane < 32 ? kvg[lane * 8 + k] : 0.f; }
    for (int rowb = (blockIdx.x * 8 + wv) * 2; rowb < MT; rowb += gridDim.x * 16) {
        float v[2][8], cq[2][8], kv[2][8], x1[2], x2[2];
#pragma unroll
        for (int rr = 0; rr < 2; ++rr) {
            const bf16_t* r = IN1 + (size_t)(rowb + rr) * 1792;
            unpack8(*(const u32x4*)(r + 512 + lane * 8), v[rr]);
            u32x4 z = {0u, 0u, 0u, 0u};
            unpack8(lane < 48 ? *(const u32x4*)(r + 1024 + lane * 8) : z, cq[rr]);
            unpack8(lane < 32 ? *(const u32x4*)(r + 1408 + lane * 8) : z, kv[rr]);
            x1[rr] = lane < 16 ? bf2f(r[1664 + lane]) : 0.f; x2[rr] = lane < 16 ? bf2f(r[1680 + lane]) : 0.f;
        }
        float sv[2], sq[2], sk[2];
#pragma unroll
        for (int rr = 0; rr < 2; ++rr) {
            sv[rr] = 0.f; sq[rr] = 0.f; sk[rr] = 0.f;
#pragma unroll
            for (int k = 0; k < 8; ++k) { sv[rr] += v[rr][k]; sq[rr] += cq[rr][k] * cq[rr][k]; sk[rr] += kv[rr][k] * kv[rr][k]; }
        }
#pragma unroll
        for (int of = 32; of > 0; of >>= 1)
#pragma unroll
            for (int rr = 0; rr < 2; ++rr) { sv[rr] += __shfl_xor(sv[rr], of); sq[rr] += __shfl_xor(sq[rr], of); sk[rr] += __shfl_xor(sk[rr], of); }
        float var[2];
#pragma unroll
        for (int rr = 0; rr < 2; ++rr) {
            const float mu = sv[rr] * (1.f / 512.f); var[rr] = 0.f;
#pragma unroll
            for (int k = 0; k < 8; ++k) { v[rr][k] -= mu; var[rr] += v[rr][k] * v[rr][k]; }
        }
#pragma unroll
        for (int of = 32; of > 0; of >>= 1) { var[0] += __shfl_xor(var[0], of); var[1] += __shfl_xor(var[1], of); }
#pragma unroll
        for (int rr = 0; rr < 2; ++rr) {
            const int row = rowb + rr;
            bf16_t* r = IN1 + (size_t)row * 1792;
            {
                const float rs = rsqrtf(var[rr] * (1.f / 512.f) + EPS);
#pragma unroll
                for (int k = 0; k < 8; ++k) v[rr][k] = v[rr][k] * rs * glng[k] + glnb[k];
                *(u32x4*)(r + 512 + lane * 8) = pack8(v[rr]);
                if (row >= NP) {
                    float* o = p.out + O_SGUV_S + (size_t)(row - NP) * 512 + lane * 8;
                    *(f32x4*)o = (f32x4){v[rr][0], v[rr][1], v[rr][2], v[rr][3]}; *(f32x4*)(o + 4) = (f32x4){v[rr][4], v[rr][5], v[rr][6], v[rr][7]};
                }
            }
            if (lane < 48) {
                const float rs = rsqrtf(sq[rr] * (1.f / 384.f) + EPS);
#pragma unroll
                for (int k = 0; k < 8; ++k) cq[rr][k] = cq[rr][k] * rs * gq[k];
                *(u32x4*)(r + 1024 + lane * 8) = pack8(cq[rr]);
            }
            if (lane < 32) {
                const float rs = rsqrtf(sk[rr] * (1.f / 256.f) + EPS);
#pragma unroll
                for (int k = 0; k < 8; ++k) kv[rr][k] = kv[rr][k] * rs * gkv[k];
                u32x4 w = pack8(kv[rr]);
                *(u32x4*)(r + 1408 + lane * 8) = w;
                float* o = row < NP ? p.out + O_CKV_P + (size_t)row * 256 + lane * 8 : p.out + O_CKV_S + (size_t)(row - NP) * 256 + lane * 8;
                *(f32x4*)o = (f32x4){kv[rr][0], kv[rr][1], kv[rr][2], kv[rr][3]}; *(f32x4*)(o + 4) = (f32x4){kv[rr][4], kv[rr][5], kv[rr][6], kv[rr][7]};
                if (row >= NP) { int b = (row - NP) >> 4, t = (row - NP) & 15; *(u32x4*)(KC + ((size_t)b * 4112 + 4096 + t) * 288 + lane * 8) = w; }
            }
            if (lane < 16) {
                float sn, c; rope_sc(row_pos(row), crev, sn, c);
                float o1 = x1[rr] * c - x2[rr] * sn, o2 = x1[rr] * sn + x2[rr] * c;
                bf16_t b1 = f2bf(o1), b2 = f2bf(o2);
                r[1664 + lane] = b1; r[1680 + lane] = b2;
                float* o = row < NP ? p.out + O_KPE_P + (size_t)row * 32 : p.out + O_KPE_S + (size_t)(row - NP) * 32;
                o[lane] = o1; o[lane + 16] = o2;
                if (row >= NP) { int b = (row - NP) >> 4, t = (row - NP) & 15; bf16_t* kc = KC + ((size_t)b * 4112 + 4096 + t) * 288 + 256; kc[lane] = b1; kc[lane + 16] = b2; }
            }
        }
    }
}

DEVI void kc_item(const Params& p, int item) {
    const int tid = get_tid();
    bf16_t* KC = (bf16_t*)(p.ws + WS_KC);
    const float* cc = p.in[5]; const float* cp = p.in[6];
#pragma unroll
    for (int e = 0; e < 8; ++e) {
        const long id = (long)item * 4096 + e * 512 + tid;
        const long rw = id / 36; const int ch = (int)(id - rw * 36);
        const int b = (int)(rw >> 12), kk = (int)(rw & 4095);
        const float* src = ch < 32 ? cc + (size_t)rw * 256 + ch * 8 : cp + (size_t)rw * 32 + (ch - 32) * 8;
        f32x4 a = *(const f32x4*)src, bb = *(const f32x4*)(src + 4);
        u32x4 w; w.x = pk2(a[0], a[1]); w.y = pk2(a[2], a[3]); w.z = pk2(bb[0], bb[1]); w.w = pk2(bb[2], bb[3]);
        *(u32x4*)(KC + ((size_t)b * 4112 + kk) * 288 + ch * 8) = w;
    }
}

DEVI void conv_item(const Params& p, int item) {
    const int tid = get_tid(), ch = tid & 63, rs = tid >> 6;
    const bf16_t* Q = (const bf16_t*)(p.ws + WS_R1 + R1_QKVG);
    bf16_t* MX = (bf16_t*)(p.ws + WS_R1 + R1_MIXED);
    const float* wc = p.in[12];
    float w0[8], w1[8], w2[8];
#pragma unroll
    for (int k = 0; k < 8; ++k) { w0[k] = wc[ch * 8 + k]; w1[k] = wc[512 + ch * 8 + k]; w2[k] = wc[1024 + ch * 8 + k]; }
#pragma unroll 1
    for (int i = 0; i < 4; ++i) {
        int rbase = item * 32;
        if (item < 2048) { const int bi = item >> 6; rbase = ((bi & 7) * 4 + (3 - (bi >> 3))) * 2048 + (item & 63) * 32; }
        const int row = rbase + rs + i * 8;
        const bool samp = row >= NP;
        const int t = samp ? (row - NP) & 15 : row & 2047;
        const int b = samp ? (row - NP) >> 4 : row >> 11;
        float cin[3][8];
#pragma unroll
        for (int j = 0; j < 3; ++j) {
            if (t - j >= 0) {
                const bf16_t* rr = Q + (size_t)(row - j) * 3072;
                float a[8], u[8]; unpack8(*(const u32x4*)(rr + 2048 + ch * 8), a); unpack8(*(const u32x4*)(rr + 2560 + ch * 8), u);
#pragma unroll
                for (int k = 0; k < 8; ++k) cin[j][k] = a[k] * u[k];
            } else if (samp) {
                const float* pv = p.in[4] + ((size_t)b * 2 + (2 + t - j)) * 512 + ch * 8;
#pragma unroll
                for (int k = 0; k < 8; ++k) cin[j][k] = pv[k];
            } else {
#pragma unroll
                for (int k = 0; k < 8; ++k) cin[j][k] = 0.f;
            }
        }
        {
            float kf[8], vf[8];
            unpack8(*(const u32x4*)(Q + (size_t)row * 3072 + 512 + ch * 8), kf); unpack8(*(const u32x4*)(Q + (size_t)row * 3072 + 1024 + ch * 8), vf);
            float* ok = p.out + (samp ? O_SBK_S + (size_t)(row - NP) * 512 : O_SBK_P + (size_t)row * 512) + ch * 8;
            float* ov = p.out + (samp ? O_SBV_S + (size_t)(row - NP) * 512 : O_SBV_P + (size_t)row * 512) + ch * 8;
            *(f32x4*)ok = (f32x4){kf[0], kf[1], kf[2], kf[3]}; *(f32x4*)(ok + 4) = (f32x4){kf[4], kf[5], kf[6], kf[7]};
            *(f32x4*)ov = (f32x4){vf[0], vf[1], vf[2], vf[3]}; *(f32x4*)(ov + 4) = (f32x4){vf[4], vf[5], vf[6], vf[7]};
        }
        float gp[8]; unpack8(*(const u32x4*)(Q + (size_t)row * 3072 + 1536 + ch * 8), gp);
        float o[8];
#pragma unroll
        for (int k = 0; k < 8; ++k) o[k] = gp[k] * (w0[k] * cin[2][k] + w1[k] * cin[1][k] + w2[k] * cin[0][k]);
        *(u32x4*)(MX + (size_t)row * 1024 + 512 + ch * 8) = pack8(o);
        const int tl = samp ? 14 : 2046;
        if (t >= tl) {
            float* o2 = p.out + (samp ? O_CONV_S : O_CONV_P) + ((size_t)b * 2 + (t - tl)) * 512 + ch * 8;
#pragma unroll
            for (int k = 0; k < 8; ++k) o2[k] = cin[0][k];
        }
    }
}

DEVI s4v tr_read(const unsigned char* lp) { return __builtin_amdgcn_ds_read_tr16_b64_v4i16((__attribute__((address_space(3))) s4v*)(lp)); }

DEVI void sgu_item(const Params& p, int sg, unsigned char* smem) {
    const int tid = get_tid(), wv = tid >> 6, lane = tid & 63;
    int g, row0, L;
    if (sg < 2048) { const int chunk = sg >> 2; g = sg & 3; row0 = (chunk >> 4) * 2048 + (chunk & 15) * 128; L = 128; }
    else { const int s2 = sg - 2048; g = s2 & 3; row0 = NP + (s2 >> 2) * 16; L = 16; }
    bf16_t* IN1 = (bf16_t*)(p.ws + WS_R1 + R1_IN1);
    bf16_t* MX = (bf16_t*)(p.ws + WS_R1 + R1_MIXED2);
    const float* Wg = p.in[17] + (size_t)g * 128 * 128;
    const float* bs = p.in[18] + g * 128;
    constexpr int STR = 272;
    unsigned char* Wl = smem; unsigned char* Vl = smem + 128 * STR;
#pragma unroll
    for (int e = 0; e < 8; ++e) {
        int idx = tid + e * 512, t = idx >> 5, s4 = (idx & 31) * 4;
        f32x4 w = {0.f, 0.f, 0.f, 0.f};
        if (t < L) w = *(const f32x4*)(Wg + t * 128 + s4);
        float o[4];
#pragma unroll
        for (int k = 0; k < 4; ++k) o[k] = (s4 + k <= t && s4 + k < L) ? w[k] : 0.f;
        u32x2 pw; pw.x = pk2(o[0], o[1]); pw.y = pk2(o[2], o[3]);
        *(u32x2*)(Wl + t * STR + s4 * 2) = pw;
    }
#pragma unroll
    for (int e = 0; e < 4; ++e) {
        int idx = tid + e * 512, s = idx >> 4, c = idx & 15;
        u32x4 w = {0u, 0u, 0u, 0u};
        if (s < L) w = *(const u32x4*)(IN1 + (size_t)(row0 + s) * 1792 + 512 + g * 128 + c * 8);
        *(u32x4*)(Vl + s * STR + c * 16) = w;
    }
    __syncthreads();
    const int tb = wv >> 1, r = lane & 31, h = lane >> 5, grp = lane >> 4, q = (lane & 15) >> 2, pp = lane & 3;
    f32x16 acc[2] = {};
    if (tb * 32 < L) {
        for (int sb = 0; sb <= tb; ++sb) {
#pragma unroll
            for (int st = 0; st < 2; ++st) {
                bf16x8 a = *(const bf16x8*)(Wl + (tb * 32 + r) * STR + (sb * 32 + st * 16 + 8 * h) * 2);
#pragma unroll
                for (int d2 = 0; d2 < 2; ++d2) {
                    const int db = (wv & 1) * 2 + d2;
                    const unsigned char* vp = Vl + (sb * 32 + st * 16 + 8 * h + q) * STR + (db * 32 + 16 * (grp & 1) + 4 * pp) * 2;
                    s4v lo = tr_read(vp), hi = tr_read(vp + 4 * STR);
                    bf16x8 bfr = __builtin_shufflevector(lo, hi, 0, 1, 2, 3, 4, 5, 6, 7);
                    acc[d2] = __builtin_amdgcn_mfma_f32_32x32x16_bf16(a, bfr, acc[d2], 0, 0, 0);
                }
            }
        }
    }
    __syncthreads();
    float* Sl = (float*)smem;
    if (tb * 32 < L) {
#pragma unroll
        for (int d2 = 0; d2 < 2; ++d2) {
            const int d = ((wv & 1) * 2 + d2) * 32 + r;
#pragma unroll
            for (int reg = 0; reg < 16; ++reg) {
                const int t = tb * 32 + (reg & 3) + 8 * (reg >> 2) + 4 * h;
                Sl[t * 132 + d] = acc[d2][reg];
            }
        }
    }
    __syncthreads();
#pragma unroll
    for (int e = 0; e < 4; ++e) {
        const int idx = tid + e * 512, t = idx >> 4, c = idx & 15;
        if (t < L) {
            float u[8]; unpack8(*(const u32x4*)(IN1 + (size_t)(row0 + t) * 1792 + g * 128 + c * 8), u);
            const f32x4 s0 = *(const f32x4*)(Sl + t * 132 + c * 8), s1 = *(const f32x4*)(Sl + t * 132 + c * 8 + 4);
            const float bt = bs[t];
            float o[8];
#pragma unroll
            for (int k = 0; k < 4; ++k) { o[k] = u[k] * (s0[k] + bt); o[4 + k] = u[4 + k] * (s1[k] + bt); }
            *(u32x4*)(MX + (size_t)(row0 + t) * 1024 + g * 128 + c * 8) = pack8(o);
        }
    }
}

template <int MODE> struct AC;
template <> struct AC<0> { static constexpr int DQK = 64, DV = 64, KSTR = 144, VSTR = 144, NST = 2; };
template <> struct AC<1> { static constexpr int DQK = 96, DV = 64, KSTR = 208, VSTR = 144, NST = 3; };
template <> struct AC<2> { static constexpr int DQK = 288, DV = 256, KSTR = 592, VSTR = 592, NST = 5; };
constexpr int SM_V = 40960, SM_FLAG = 65536;

DEVI u32x4 ld_f32x8_bf16(const float* src) {
    f32x4 a = *(const f32x4*)src, b = *(const f32x4*)(src + 4);
    u32x4 w; w.x = pk2(a[0], a[1]); w.y = pk2(a[2], a[3]); w.z = pk2(b[0], b[1]); w.w = pk2(b[2], b[3]); return w;
}

template <int MODE>
DEVI void attn_item(const Params& p, int item, unsigned char* smem) {
    typedef AC<MODE> C;
    constexpr int KS = C::DQK / 16, DB = (MODE == 2) ? 4 : C::DV / 32, NST = C::NST, NQF = (MODE == 2) ? 1 : KS;
    const int tid = get_tid(), wv = tid >> 6, lane = tid & 63;
    const int r = lane & 31, h = lane >> 5, grp = lane >> 4, q4 = (lane & 15) >> 2, pp = lane & 3;
    unsigned char* Ks = smem;
    unsigned char* Vs = (MODE == 2) ? smem : smem + SM_V;
    unsigned char* Qs = smem + SM_V;
    volatile int* flags = (volatile int*)(smem + SM_FLAG);

    int b = 0, hd = 0, q0 = 0, kt_last = 0; bool samp = false;
    if constexpr (MODE == 0) {
        if (item < 2048) { const int bi = item >> 6, qb = 7 - ((item >> 3) & 7); b = (bi & 7) * 4 + (3 - (bi >> 3)); hd = item & 7; q0 = qb * 256; kt_last = (q0 + 255) >> 6; }
        else { const int s = item - 2048; b = s >> 3; hd = s & 7; samp = true; q0 = 4096; kt_last = 64; }
    } else if constexpr (MODE == 1) {
        const int qb = 7 - (item >> 8); b = (item & 255) >> 3; hd = item & 7; q0 = qb * 256; kt_last = (q0 + 255) >> 6;
    } else { b = item; kt_last = 64; }
    const bf16_t* QKVG = (const bf16_t*)(p.ws + WS_R1 + R1_QKVG);
    const bf16_t* IN1 = (const bf16_t*)(p.ws + WS_R1 + R1_IN1);
    const bf16_t* QF = (const bf16_t*)(p.ws + WS_R1 + R1_QF);
    const bf16_t* KVUP = (const bf16_t*)(p.ws + WS_R1 + R1_KVUP);
    const bf16_t* QLAT = (const bf16_t*)(p.ws + WS_R1 + R1_QLAT);
    const bf16_t* KC = (const bf16_t*)(p.ws + WS_KC);

    bool wactive; int qpos = 0; bool qvalid = true; size_t orow = 0;
    bf16x8 qf[NQF];
    const int rg = wv & 3, dvh = (MODE == 2) ? (wv >> 2) : 0;
    if constexpr (MODE == 0) {
        wactive = samp ? (wv == 0) : true;
        int qi = samp ? (r & 15) : (wv * 32 + r);
        qvalid = samp ? (r < 16) : true;
        qpos = q0 + qi;
        orow = samp ? (size_t)(NP + b * 16 + qi) : (size_t)(b * 2048 + q0 + qi);
        const bf16_t* qp = QKVG + orow * 3072 + hd * 64;
#pragma unroll
        for (int st = 0; st < KS; ++st) qf[st] = *(const bf16x8*)(qp + st * 16 + 8 * h);
    } else if constexpr (MODE == 1) {
        wactive = true; qpos = q0 + wv * 32 + r; orow = (size_t)(b * 2048 + qpos);
        const bf16_t* qp = QF + orow * 768 + hd * 96;
#pragma unroll
        for (int st = 0; st < KS; ++st) qf[st] = *(const bf16x8*)(qp + st * 16 + 8 * h);
#pragma unroll
        for (int j = 0; j < 8; ++j) {
            float crev; rope_consts(8 * h + j, crev);
            float sn, cs; rope_sc(qpos, crev, sn, cs);
            const float x1 = bf2f((unsigned short)qf[4][j]), x2 = bf2f((unsigned short)qf[5][j]);
            qf[4][j] = (short)f2bf(x1 * cs - x2 * sn); qf[5][j] = (short)f2bf(x1 * sn + x2 * cs);
        }
    } else {
        wactive = true;
        for (int id = tid; id < 128 * 36; id += 512) {
            const int rr = id / 36, ch = id % 36, hh = rr >> 4, t = rr & 15;
            u32x4 w = ch < 32 ? *(const u32x4*)(QLAT + (size_t)(b * 16 + t) * 2048 + hh * 256 + ch * 8)
                              : *(const u32x4*)(QF + (size_t)(NP + b * 16 + t) * 768 + hh * 96 + 64 + (ch - 32) * 8);
            *(u32x4*)(Qs + rr * 592 + ch * 16) = w;
        }
        __syncthreads();
        for (int id = tid; id < 128 * 16; id += 512) {
            const int rr = id >> 4, i = id & 15, t = rr & 15;
            bf16_t* qrow = (bf16_t*)(Qs + rr * 592);
            float crev; rope_consts(i, crev);
            float sn, cs; rope_sc(4096 + t, crev, sn, cs);
            const float x1 = bf2f(qrow[256 + i]), x2 = bf2f(qrow[272 + i]);
            qrow[256 + i] = f2bf(x1 * cs - x2 * sn); qrow[272 + i] = f2bf(x1 * sn + x2 * cs);
        }
    }
    const int wave_qmax = q0 + wv * 32 + 31;
    const int wave_chunk = (q0 + wv * 32) >> 6;

    f32x16 O[DB];
#pragma unroll
    for (int d = 0; d < DB; ++d) O[d] = (f32x16){};
    float carry = (MODE == 0) ? 1.f : 0.f, mrun = -INFINITY, lrun = 0.f;

    constexpr int NH = (MODE == 2) ? 1 : 2;
    u32x4 stg[NH][NST];
    auto issue = [&](int kT) {
#pragma unroll
        for (int hf = 0; hf < NH; ++hf) {
            const int kt = kT * NH + hf;
#pragma unroll
            for (int i = 0; i < NST; ++i) {
                u32x4 w = {0u, 0u, 0u, 0u};
                if constexpr (MODE == 0) {
                    const int row = tid >> 3, ch = tid & 7, kk = kt * 64 + row;
                    const int off = (i == 0 ? 512 : 1024) + hd * 64 + ch * 8;
                    if (!samp) w = *(const u32x4*)(QKVG + (size_t)(b * 2048 + kk) * 3072 + off);
                    else if (kk < 4096) w = ld_f32x8_bf16(p.in[i == 0 ? 2 : 3] + (((size_t)b * 4096 + kk) * 8 + hd) * 64 + ch * 8);
                    else if (kk < 4112) w = *(const u32x4*)(QKVG + (size_t)(NP + b * 16 + kk - 4096) * 3072 + off);
                } else if constexpr (MODE == 1) {
                    if (i == 0) { const int row = tid >> 3, ch = tid & 7; w = *(const u32x4*)(KVUP + (size_t)(b * 2048 + kt * 64 + row) * 1024 + 512 + hd * 64 + ch * 8); }
                    else {
                        const int id = tid + (i - 1) * 512;
                        if (id < 768) { const int row = id / 12, ch = id % 12; const size_t gr = (size_t)(b * 2048 + kt * 64 + row);
                            w = ch < 8 ? *(const u32x4*)(KVUP + gr * 1024 + hd * 64 + ch * 8) : *(const u32x4*)(IN1 + gr * 1792 + 1664 + (ch - 8) * 8); }
                    }
                } else {
                    const int id = tid + i * 512;
                    if (id < 2304) { const int row = id / 36, ch = id % 36, kk = kt * 64 + row;
                        if (kk < 4112) w = *(const u32x4*)(KC + ((size_t)b * 4112 + kk) * 288 + ch * 8); }
                }
                stg[hf][i] = w;
            }
        }
    };
    auto commit = [&]() {
#pragma unroll
        for (int hf = 0; hf < NH; ++hf) {
            unsigned char* Kh = Ks + hf * 64 * C::KSTR; unsigned char* Vh = Vs + hf * 64 * C::VSTR;
#pragma unroll
            for (int i = 0; i < NST; ++i) {
                if constexpr (MODE == 0) { const int row = tid >> 3, ch = tid & 7; *(u32x4*)((i == 0 ? Kh : Vh) + row * 144 + ch * 16) = stg[hf][i]; }
                else if constexpr (MODE == 1) {
                    if (i == 0) { const int row = tid >> 3, ch = tid & 7; *(u32x4*)(Vh + row * C::VSTR + ch * 16) = stg[hf][0]; }
                    else { const int id = tid + (i - 1) * 512; if (id < 768) { const int row = id / 12, ch = id % 12; *(u32x4*)(Kh + row * C::KSTR + ch * 16) = stg[hf][i]; } }
                } else { const int id = tid + i * 512; if (id < 2304) { const int row = id / 36, ch = id % 36; *(u32x4*)(Kh + row * C::KSTR + ch * 16) = stg[hf][i]; } }
            }
        }
    };

    const int kT_last = kt_last / NH;
    issue(kT_last);
    int done = wactive ? 0 : 1, par = 0;
    for (int kT = kT_last; kT >= 0; --kT) {
        if constexpr (MODE == 0) { if (lane == 0) flags[par * 8 + wv] = done; }
        __syncthreads();
        if constexpr (MODE == 0) {
            int all = 1;
#pragma unroll
            for (int w = 0; w < 8; ++w) all &= flags[par * 8 + w];
            par ^= 1;
            if (all) break;
        }
        commit();
        __syncthreads();
        if (kT > 0) issue(kT - 1);
      f32x16 SA[NH][2]; bool relq[NH];
#pragma unroll
      for (int hfi = 0; hfi < NH; ++hfi) {
        const int hf = NH - 1 - hfi, kt = kT * NH + hf;
        unsigned char* Ks = smem + hf * 64 * C::KSTR;
        bool rel = wactive && (kt <= kt_last);
        if constexpr (MODE == 0) rel = rel && !done && (samp || kt * 64 < wave_qmax);
        if constexpr (MODE == 1) rel = rel && (kt <= wave_chunk);
        relq[hf] = rel;
        SA[hf][0] = (f32x16){}; SA[hf][1] = (f32x16){};
        if (rel) {
                constexpr int CH = (KS % 6 == 0) ? 6 : 4;
#pragma unroll
                for (int c0 = 0; c0 < KS; c0 += CH) {
                    bf16x8 ka[2][CH], qb[CH];
#pragma unroll
                    for (int s = 0; s < CH; ++s) {
                        ka[0][s] = *(const bf16x8*)(Ks + (r) * C::KSTR + ((c0 + s) * 16 + 8 * h) * 2);
                        ka[1][s] = *(const bf16x8*)(Ks + (32 + r) * C::KSTR + ((c0 + s) * 16 + 8 * h) * 2);
                        if constexpr (MODE == 2) qb[s] = *(const bf16x8*)(Qs + (rg * 32 + r) * 592 + ((c0 + s) * 16 + 8 * h) * 2); else qb[s] = qf[c0 + s];
                    }
                    __builtin_amdgcn_sched_barrier(0);
#pragma unroll
                    for (int s = 0; s < CH; ++s) {
                        SA[hf][0] = __builtin_amdgcn_mfma_f32_32x32x16_bf16(ka[0][s], qb[s], SA[hf][0], 0, 0, 0);
                        SA[hf][1] = __builtin_amdgcn_mfma_f32_32x32x16_bf16(ka[1][s], qb[s], SA[hf][1], 0, 0, 0);
                    }
                }
        }
      }
#pragma unroll
      for (int hfi = 0; hfi < NH; ++hfi) {
        const int hf = NH - 1 - hfi, kt = kT * NH + hf;
        unsigned char* Vs = ((MODE == 2) ? smem : smem + SM_V) + hf * 64 * C::VSTR;
        bool rel = relq[hf];
        if constexpr (MODE == 0) rel = rel && !done;
        if (rel) {
            f32x16 (&S)[2] = SA[hf];
            bf16x8 pf[2][2];
            if constexpr (MODE == 0) {
#pragma unroll
                for (int kbi = 0; kbi < 2; ++kbi) {
                    const int kb = 1 - kbi;
                    float bt[16], qv[16];
#pragma unroll
                    for (int reg = 0; reg < 16; ++reg) {
                        const int kk = kt * 64 + kb * 32 + (reg & 3) + 8 * (reg >> 2) + 4 * h;
                        const bool v = qvalid && (kk < qpos);
                        const float t = __builtin_amdgcn_exp2f(fminf(S[kb][reg], 120.f));
                        const float q = __builtin_amdgcn_rcpf(1.f + t);
                        bt[reg] = v ? t * q : 0.f; qv[reg] = v ? q : 1.f;
                    }
                    float G[4], PG[4], T[4];
#pragma unroll
                    for (int g = 0; g < 4; ++g) { G[g] = (qv[4 * g] * qv[4 * g + 1]) * (qv[4 * g + 2] * qv[4 * g + 3]); PG[g] = __shfl_xor(G[g], 32); }
                    T[3] = 1.f; T[2] = G[3] * PG[3]; T[1] = T[2] * (G[2] * PG[2]); T[0] = T[1] * (G[1] * PG[1]);
                    const float total = T[0] * (G[0] * PG[0]);
                    float w[16];
#pragma unroll
                    for (int g = 0; g < 4; ++g) {
                        float run = carry * T[g] * (h == 0 ? PG[g] : 1.f);
#pragma unroll
                        for (int i = 3; i >= 0; --i) {
                            const int reg = 4 * g + i;
                            w[reg] = bt[reg] * run;
                            run *= qv[reg];
                        }
                    }
                    carry *= total;
#pragma unroll
                    for (int s = 0; s < 2; ++s) {
                        u32x4 u; u.x = pk2(w[8 * s], w[8 * s + 1]); u.y = pk2(w[8 * s + 2], w[8 * s + 3]); u.z = pk2(w[8 * s + 4], w[8 * s + 5]); u.w = pk2(w[8 * s + 6], w[8 * s + 7]);
                        pf[kb][s] = __builtin_bit_cast(bf16x8, u);
                    }
                }
                done = __all((!qvalid) || (carry < 1e-36f)) ? 1 : 0;
            } else {
                float mx = -INFINITY;
#pragma unroll
                for (int kb = 0; kb < 2; ++kb)
#pragma unroll
                    for (int reg = 0; reg < 16; ++reg) {
                        if constexpr (MODE == 2) { const int kk = kt * 64 + kb * 32 + (reg & 3) + 8 * (reg >> 2) + 4 * h; if (kk >= 4112) S[kb][reg] = -INFINITY; }
                        mx = fmaxf(mx, S[kb][reg]);
                    }
                mx = fmaxf(mx, __shfl_xor(mx, 32));
                const float mn = fmaxf(mrun, mx);
                const float alpha = __builtin_amdgcn_exp2f(mrun - mn);
                mrun = mn;
                float ls = 0.f;
#pragma unroll
                for (int kb = 0; kb < 2; ++kb) {
                    float w[16];
#pragma unroll
                    for (int reg = 0; reg < 16; ++reg) { w[reg] = __builtin_amdgcn_exp2f(S[kb][reg] - mn); ls += w[reg]; }
#pragma unroll
                    for (int s = 0; s < 2; ++s) {
                        u32x4 u; u.x = pk2(w[8 * s], w[8 * s + 1]); u.y = pk2(w[8 * s + 2], w[8 * s + 3]); u.z = pk2(w[8 * s + 4], w[8 * s + 5]); u.w = pk2(w[8 * s + 6], w[8 * s + 7]);
                        pf[kb][s] = __builtin_bit_cast(bf16x8, u);
                    }
                }
                lrun = lrun * alpha + ls;
                if (!__all(alpha == 1.f)) {
#pragma unroll
                    for (int d = 0; d < DB; ++d) O[d] = O[d] * alpha;
                }
            }
#pragma unroll
            for (int d = 0; d < DB; ++d) {
                bf16x8 va[2][2];
#pragma unroll
                for (int kb = 0; kb < 2; ++kb)
#pragma unroll
                    for (int s = 0; s < 2; ++s) {
                        const unsigned char* vp = Vs + (kb * 32 + 16 * s + 4 * h + q4) * C::VSTR + ((dvh * 4 + d) * 32 + 16 * (grp & 1) + 4 * pp) * 2;
                        s4v lo = tr_read(vp), hi = tr_read(vp + 8 * C::VSTR);
                        va[kb][s] = __builtin_shufflevector(lo, hi, 0, 1, 2, 3, 4, 5, 6, 7);
                    }
                __builtin_amdgcn_sched_barrier(0);
#pragma unroll
                for (int kb = 0; kb < 2; ++kb)
#pragma unroll
                    for (int s = 0; s < 2; ++s) O[d] = __builtin_amdgcn_mfma_f32_32x32x16_bf16(va[kb][s], pf[kb][s], O[d], 0, 0, 0);
            }
        }
      }
    }
    if (MODE == 0 || MODE == 1) {
        float inv = 1.f;
        if constexpr (MODE == 1) { const float l = lrun + __shfl_xor(lrun, 32); inv = 1.f / l; }
        if (wactive && qvalid) {
            bf16_t* op = (MODE == 0) ? (bf16_t*)(p.ws + WS_R1 + R1_MIXED) + orow * 1024 + hd * 64
                                     : (bf16_t*)(p.ws + WS_R1 + R1_MIXED2) + orow * 1024 + 512 + hd * 64;
#pragma unroll
            for (int d = 0; d < DB; ++d)
#pragma unroll
                for (int g = 0; g < 4; ++g) {
                    u32x2 w; w.x = pk2(O[d][4 * g] * inv, O[d][4 * g + 1] * inv); w.y = pk2(O[d][4 * g + 2] * inv, O[d][4 * g + 3] * inv);
                    *(u32x2*)(op + d * 32 + 8 * g + 4 * h) = w;
                }
        }
    } else {
        const float l = lrun + __shfl_xor(lrun, 32);
        const float inv = 1.f / l;
        __syncthreads();
        float* OL = (float*)smem;
        if (wactive) {
            const int rr = rg * 32 + r;
#pragma unroll
            for (int d = 0; d < DB; ++d)
#pragma unroll
                for (int g = 0; g < 4; ++g)
                    *(f32x4*)(OL + rr * 256 + (dvh * 4 + d) * 32 + 8 * g + 4 * h) = (f32x4){O[d][4 * g] * inv, O[d][4 * g + 1] * inv, O[d][4 * g + 2] * inv, O[d][4 * g + 3] * inv};
        }
        __syncthreads();
        const int hh = tid >> 6, v = tid & 63;
        const float* wuv = p.in[23] + (size_t)hh * 256 * 64 + v;
        float acc[16];
#pragma unroll
        for (int t = 0; t < 16; ++t) acc[t] = 0.f;
        for (int c = 0; c < 256; ++c) {
            const float w = wuv[(size_t)c * 64];
#pragma unroll
            for (int t = 0; t < 16; ++t) acc[t] += OL[(hh * 16 + t) * 256 + c] * w;
        }
        bf16_t* MX = (bf16_t*)(p.ws + WS_R1 + R1_MIXED2);
#pragma unroll
        for (int t = 0; t < 16; ++t) MX[(size_t)(NP + b * 16 + t) * 1024 + 512 + hh * 64 + v] = f2bf(acc[t]);
    }
}

#define XB_TMO      128
#define XB_XCNT(j)  (256  + 64 * (j))
#define XB_XSUB(j)  (1280 + 64 * (j))
#define XB_XGEN(j)  (2304 + 64 * (j))
#define XB_TOP      3328
#define XB_TOPGEN   3392
#define XCD_BAR_WORDS 3456
#define XB_SPIN_CAP (1u << 21)
DEVI unsigned xb_ld(unsigned* p)              { return __hip_atomic_load(p, __ATOMIC_RELAXED, __HIP_MEMORY_SCOPE_AGENT); }
DEVI unsigned xb_add(unsigned* p, unsigned v) { return __hip_atomic_fetch_add(p, v, __ATOMIC_RELAXED, __HIP_MEMORY_SCOPE_AGENT); }
DEVI unsigned xb_xcc_id() { return (unsigned)__builtin_amdgcn_s_getreg((3 << 11) | 20) & 0xFu; }
#define XB_SPIN(cond, bar) do { unsigned _sp = 0; while (cond) { __builtin_amdgcn_s_sleep(1); \
    if ((++_sp & 255u) == 0u) { if (xb_ld(&(bar)[XB_TMO])) break; if (_sp > XB_SPIN_CAP) { atomicAdd(&(bar)[XB_TMO], 1u); break; } } } } while (0)
struct XcdBarrier { unsigned* bar; unsigned x; volatile LAS unsigned* st; };
DEVI XcdBarrier xcd_barrier_post(unsigned* bar, volatile LAS unsigned* st) {
    XcdBarrier b; b.bar = bar; b.x = xb_xcc_id(); b.st = st;
    if (threadIdx.x == 0) (void)xb_add(&bar[XB_XCNT(b.x)], 1u);
    return b;
}
DEVI void xcd_barrier_complete(unsigned* bar, unsigned x, unsigned& nloc, unsigned& nx) {
    const unsigned G = gridDim.x * gridDim.y * gridDim.z;
    unsigned sum, cnt, mine, sp = 0u;
    for (;;) {
        sum = 0u; cnt = 0u; mine = 0u;
#pragma unroll
        for (unsigned j = 0; j < 16; ++j) { const unsigned c = xb_ld(&bar[XB_XCNT(j)]); sum += c; cnt += (c > 0u) ? 1u : 0u; mine = (j == x) ? c : mine; }
        if (sum == G) break;
        __builtin_amdgcn_s_sleep(1);
        if ((++sp & 255u) == 0u) { if (xb_ld(&bar[XB_TMO])) break; if (sp > XB_SPIN_CAP) { atomicAdd(&bar[XB_TMO], 1u); break; } }
    }
    nloc = mine > 0u ? mine : 1u; nx = cnt > 0u ? cnt : 1u;
}
DEVI void xcd_barrier(const XcdBarrier& b) {
    asm volatile("s_waitcnt vmcnt(0)" ::: "memory");
    __syncthreads();
    if (threadIdx.x == 0) {
        unsigned* bar = b.bar;
        __builtin_amdgcn_s_waitcnt(0);
        unsigned nloc = b.st[0], nx = b.st[1];
        if (nloc == 0u) { xcd_barrier_complete(bar, b.x, nloc, nx); b.st[0] = nloc; b.st[1] = nx; }
        const unsigned old = xb_add(&bar[XB_XSUB(b.x)], 1u);
        const unsigned gen = old / nloc;
        if (old + 1u == (gen + 1u) * nloc) {
            __builtin_amdgcn_fence(__ATOMIC_RELEASE, "agent");
            asm volatile("s_waitcnt vmcnt(0)" ::: "memory");
            const unsigned og = xb_add(&bar[XB_TOP], 1u);
            const unsigned tg = og / nx;
            if (og + 1u == (tg + 1u) * nx) xb_add(&bar[XB_TOPGEN], 1u);
            else XB_SPIN(xb_ld(&bar[XB_TOPGEN]) == tg, bar);
            __builtin_amdgcn_fence(__ATOMIC_ACQUIRE, "agent");
            xb_add(&bar[XB_XGEN(b.x)], 1u);
            asm volatile("s_waitcnt vmcnt(0)" ::: "memory");
        } else {
            XB_SPIN(xb_ld(&bar[XB_XGEN(b.x)]) == gen, bar);
            __builtin_amdgcn_fence(__ATOMIC_ACQUIRE, "agent");
            asm volatile("s_waitcnt vmcnt(0)" ::: "memory");
        }
    }
    __syncthreads();
}

DEVI int next_item(unsigned* ctr, int* slot) {
    __syncthreads();
    if (threadIdx.x == 0) *slot = (int)atomicAdd(ctr, 1u);
    __syncthreads();
    return *slot;
}

__global__ void __launch_bounds__(512) mega(Params p, int ph_lo, int ph_hi, int coop) {
    __shared__ __attribute__((aligned(16))) unsigned char smem[131072];
    __shared__ int s_item;
    __shared__ uint4 xb_words;
    if (threadIdx.x == 0) xb_words = make_uint4(0u, 0u, 0u, 0u);
    __syncthreads();
    XcdBarrier xb = xcd_barrier_post((unsigned*)(p.ws + WS_CTR), (volatile LAS unsigned*)&xb_words);
    unsigned* ctr = (unsigned*)(p.ws + WS_CTR);
    bf16_t* shm = (bf16_t*)smem;
    unsigned char* ws = p.ws;
    bf16_t* H = (bf16_t*)(ws + WS_H);
    bf16_t* Ob = (bf16_t*)(ws + WS_O);
    bf16_t* R1 = (bf16_t*)(ws + WS_R1);

    for (int ph = ph_lo; ph < ph_hi; ++ph) {
        if (ph > ph_lo && coop) { if (ph == 1) cg::this_grid().sync(); else xcd_barrier(xb); }
        const int layer = ph >= 8 ? 1 : 0;
        constexpr int rep = 0;
        switch (ph) {
        case 0: phase_prep(p, (float*)smem); break;
        case 1: {
            bf16_t* Q = R1;
            const bf16_t* W = (const bf16_t*)(ws + WS_W1T);
            auto emit = [&](int row, int col, f32x4 v0, f32x4 v1) { bf16_t* d = Q + (size_t)row * 3072 + col; st_bf16x8(d, v0, v1); };
            gemm_run<16>(H, 1024, W, 1024, 1024, shm, [&](int i, int& br, int& bc) { const int it = blockIdx.x + i * gridDim.x; if (it >= 256 * 12) return false; int pm, pn; tile_map(it, 256, 12, pm, pn); br = pm * 256; bc = pn * 256; return true; }, emit);
            for (int it = blockIdx.x; it < 8 * 48; it += gridDim.x) gemm_small<8>(H, 1024, W, 1024, 1024, NP + (it & 7) * 64, (it >> 3) * 64, (float*)smem, emit);
        } break;
        case 2: {
            for (;;) {
                const int it = next_item(ctr + 0 + 2 * rep, &s_item);
                if (it >= 2304 + 2064 + 1152) break;
                if (it >= 2304 + 2064) { kc_item(p, it - (2304 + 2064)); continue; }
                if (it < 2 * 2064) { if (it & 1) conv_item(p, it >> 1); else attn_item<0>(p, it >> 1, smem); }
                else attn_item<0>(p, it - 2064, smem);
            }
        } break;
        case 3: case 12: {
            const bf16_t* A = R1 + (layer ? R1_MIXED2 : R1_MIXED) / 2;
            const bf16_t* W = (const bf16_t*)(ws + (layer ? WS_WO2T : WS_WO1T));
            auto emit = [&](int row, int col, f32x4 v0, f32x4 v1) { bf16_t* d = Ob + (size_t)row * 1024 + col; st_bf16x8(d, v0, v1); };
            gemm_run<16>(A, 1024, W, 1024, 1024, shm, [&](int i, int& br, int& bc) { const int it = blockIdx.x + i * gridDim.x; if (it >= 256 * 4) return false; int pm, pn; tile_map(it, 256, 4, pm, pn); br = pm * 256; bc = pn * 256; return true; }, emit);
            for (int it = blockIdx.x; it < 8 * 16; it += gridDim.x) gemm_small<8>(A, 1024, W, 1024, 1024, NP + (it & 7) * 64, (it >> 3) * 64, (float*)smem, emit);
        } break;
        case 4: phase_rowpass(p, true, p.in[8], false); break;
        case 13: phase_rowpass(p, false, p.in[8] + 1024, false); break;
        case 5: case 14: {
            bf16_t* ACT = R1;
            const bf16_t* W = (const bf16_t*)(ws + (layer ? WS_WUP1 : WS_WUP0));
            auto emit = [&](int row, int col, f32x4 v0, f32x4 v1) {
#pragma unroll
                for (int k = 0; k < 4; ++k) { float a = fmaxf(v0[k], 0.f), b2 = fmaxf(v1[k], 0.f); v0[k] = a * a; v1[k] = b2 * b2; }
                bf16_t* d = ACT + (size_t)row * 4096 + col; st_bf16x8(d, v0, v1);
            };
            gemm_run<16>(H, 1024, W, 1024, 1024, shm, [&](int i, int& br, int& bc) { const int it = blockIdx.x + i * gridDim.x; if (it >= 256 * 16) return false; int pm, pn; tile_map(it, 256, 16, pm, pn); br = pm * 256; bc = pn * 256; return true; }, emit);
            for (int it = blockIdx.x; it < 8 * 64; it += gridDim.x) gemm_small<8>(H, 1024, W, 1024, 1024, NP + (it & 7) * 64, (it >> 3) * 64, (float*)smem, emit);
        } break;
        case 6: case 15: {
            const bf16_t* ACT = R1;
            const bf16_t* W = (const bf16_t*)(ws + (layer ? WS_WDN1 : WS_WDN0));
            auto emit = [&](int row, int col, f32x4 v0, f32x4 v1) { bf16_t* d = Ob + (size_t)row * 1024 + col; st_bf16x8(d, v0, v1); };
            gemm_run<16>(ACT, 4096, W, 4096, 4096, shm, [&](int i, int& br, int& bc) { if (i >= 4) return false; const int it = blockIdx.x + (3 - i) * gridDim.x;     int pm, pn; tile_map(it, 256, 4, pm, pn); br = pm * 256; bc = pn * 256; return true; }, emit);
            for (int it = blockIdx.x; it < 8 * 16; it += gridDim.x) gemm_small<8>(ACT, 4096, W, 4096, 4096, NP + (it & 7) * 64, (it >> 3) * 64, (float*)smem, emit);
        } break;
        case 7: phase_rowpass(p, false, p.in[10], false); break;
        case 16: phase_rowpass(p, false, p.in[10] + 1024, true); break;
        case 8: {
            bf16_t* IN1 = R1;
            const bf16_t* W = (const bf16_t*)(ws + WS_W2T);
            auto emit = [&](int row, int col, f32x4 v0, f32x4 v1) { bf16_t* d = IN1 + (size_t)row * 1792 + col; st_bf16x8(d, v0, v1); };
            gemm_run<16>(H, 1024, W, 1024, 1024, shm, [&](int i, int& br, int& bc) { const int it = blockIdx.x + i * gridDim.x; if (it >= 256 * 7) return false; int pm, pn; tile_map(it, 256, 7, pm, pn); br = pm * 256; bc = pn * 256; return true; }, emit);
            for (int it = blockIdx.x; it < 8 * 28; it += gridDim.x) gemm_small<8>(H, 1024, W, 1024, 1024, NP + (it & 7) * 64, (it >> 3) * 64, (float*)smem, emit);
        } break;
        case 9: phase_l1rows(p); break;
        case 10: {
            const bf16_t* IN1 = R1;
            bf16_t* QF = R1 + R1_QF / 2; bf16_t* KVUP = R1 + R1_KVUP / 2; bf16_t* QLAT = R1 + R1_QLAT / 2;
            auto emit_kv = [&](int row, int col, f32x4 v0, f32x4 v1) { bf16_t* d = KVUP + (size_t)row * 1024 + col; st_bf16x8(d, v0, v1); };
            auto emit_qf = [&](int row, int col, f32x4 v0, f32x4 v1) { bf16_t* d = QF + (size_t)row * 768 + col; st_bf16x8(d, v0, v1); };
            auto emit_ql = [&](int row, int col, f32x4 v0, f32x4 v1) { bf16_t* d = QLAT + (size_t)(row - NP) * 2048 + col; st_bf16x8(d, v0, v1); };
            gemm_run<0>(IN1 + 1408, 1792, (const bf16_t*)(ws + WS_WKVT), 256, 256, shm, [&](int i, int& br, int& bc) { const int it = blockIdx.x + i * gridDim.x; if (it >= 256 * 4) return false; int pm, pn; tile_map(it, 256, 4, pm, pn); br = pm * 256; bc = pn * 256; return true; }, emit_kv);
            gemm_run<0>(IN1 + 1024, 1792, (const bf16_t*)(ws + WS_WUQT), 384, 384, shm, [&](int i, int& br, int& bc) { const int it = blockIdx.x + i * gridDim.x; if (it >= 256 * 3) return false; int pm, pn; tile_map(it, 256, 3, pm, pn); br = pm * 256; bc = pn * 256; return true; }, emit_qf);
            for (int it = blockIdx.x; it < 8 * 12 + 8 * 32; it += gridDim.x) {
                if (it < 96) gemm_small<4>(IN1 + 1024, 1792, (const bf16_t*)(ws + WS_WUQT), 384, 384, NP + (it & 7) * 64, (it >> 3) * 64, (float*)smem, emit_qf);
                else { const int i2 = it - 96; gemm_small<4>(IN1 + 1024, 1792, (const bf16_t*)(ws + WS_WQLT), 384, 384, NP + (i2 & 7) * 64, (i2 >> 3) * 64, (float*)smem, emit_ql); }
            }
        } break;
        case 11: {
            for (;;) {
                int it = next_item(ctr + 1 + 2 * rep, &s_item);
                if (it >= 32 + 2048 + 2176) break;
                if (it < 32) attn_item<2>(p, it, smem);
                else {
                    const int i2 = it - 32;
                    if (i2 < 2 * 2048) { if (i2 & 1) sgu_item(p, i2 >> 1, smem); else attn_item<1>(p, i2 >> 1, smem); }
                    else sgu_item(p, i2 - 2048, smem);
                }
            }
        } break;
        default: break;
        }
    }
}

constexpr int NPHASE = 17;

extern "C" void kernel_launch(void* const* d_in, const int* in_sizes, int n_in, void* d_out, int out_size, void* d_ws, size_t ws_size, hipStream_t stream) {
    static int grid = 0;
    if (grid == 0) {
        int dev = 0, cus = 0, per_cu = 0;
        hipGetDevice(&dev);
        hipDeviceGetAttribute(&cus, hipDeviceAttributeMultiprocessorCount, dev);
        hipOccupancyMaxActiveBlocksPerMultiprocessor(&per_cu, mega, 512, 0);
        if (per_cu < 1) per_cu = 1;
        grid = cus * 1;
        if (ws_size < WS_END) { fprintf(stderr, "kernel_launch: workspace too small: %zu < %zu\n", ws_size, (size_t)WS_END); grid = -1; }
    }
    if (grid < 0) return;
    Params p{};
    for (int i = 0; i < 27; ++i) p.in[i] = (const float*)d_in[i];
    p.out = (float*)d_out; p.ws = (unsigned char*)d_ws;
    hipMemsetAsync(d_ws, 0, 16384, stream);
#ifdef MULTI_LAUNCH
    for (int ph = 0; ph < NPHASE; ++ph) hipLaunchKernelGGL(mega, dim3(grid), dim3(512), 0, stream, p, ph, ph + 1, 0);
#else
    int lo = 0, hi = NPHASE, coop = 1;
    void* args[] = {&p, &lo, &hi, &coop};
    hipError_t e = hipLaunchCooperativeKernel((void*)mega, dim3(grid), dim3(512), args, 0, stream);
    if (e != hipSuccess) fprintf(stderr, "cooperative launch failed: %s (grid %d)\n", hipGetErrorString(e), grid);
#endif
}
```

```cpp
#include <hip/hip_runtime.h>
#include <hip/hip_cooperative_groups.h>
#include <cstdio>
#include <cstdint>
namespace cg = cooperative_groups;

#define DEVI __device__ __forceinline__
typedef unsigned short bf16_t;
typedef short bf16x8 __attribute__((ext_vector_type(8)));
typedef short s4v __attribute__((ext_vector_type(4)));
typedef float f32x4 __attribute__((ext_vector_type(4)));
typedef float f32x16 __attribute__((ext_vector_type(16)));
typedef unsigned u32x4 __attribute__((ext_vector_type(4)));
typedef unsigned u32x2 __attribute__((ext_vector_type(2)));

constexpr int NP = 65536;
constexpr int NS = 512;
constexpr int MT = NP + NS;
constexpr float EPS = 1e-6f;
constexpr float LOG2E = 1.4426950408889634f;
constexpr float SBQ = 0.125f * LOG2E;
constexpr float MLQ = 0.10206207261596577f * LOG2E;

constexpr size_t O_Y = 0;
constexpr size_t O_SBK_P = (size_t)MT * 1024;
constexpr size_t O_SBV_P = O_SBK_P + (size_t)NP * 512;
constexpr size_t O_CONV_P = O_SBV_P + (size_t)NP * 512;
constexpr size_t O_CKV_P = O_CONV_P + 32 * 2 * 512;
constexpr size_t O_KPE_P = O_CKV_P + (size_t)NP * 256;
constexpr size_t O_SBK_S = O_KPE_P + (size_t)NP * 32;
constexpr size_t O_SBV_S = O_SBK_S + (size_t)NS * 512;
constexpr size_t O_CONV_S = O_SBV_S + (size_t)NS * 512;
constexpr size_t O_CKV_S = O_CONV_S + 32 * 2 * 512;
constexpr size_t O_KPE_S = O_CKV_S + (size_t)NS * 256;
constexpr size_t O_SGUV_S = O_KPE_S + (size_t)NS * 32;

constexpr size_t WS_CTR = 0;
constexpr size_t WS_W1T = 16384;
constexpr size_t WS_WO1T = WS_W1T + 3072ull * 1024 * 2;
constexpr size_t WS_WUP0 = WS_WO1T + 1024ull * 1024 * 2;
constexpr size_t WS_WDN0 = WS_WUP0 + 4096ull * 1024 * 2;
constexpr size_t WS_WUP1 = WS_WDN0 + 4096ull * 1024 * 2;
constexpr size_t WS_WDN1 = WS_WUP1 + 4096ull * 1024 * 2;
constexpr size_t WS_W2T = WS_WDN1 + 4096ull * 1024 * 2;
constexpr size_t WS_WUQT = WS_W2T + 1792ull * 1024 * 2;
constexpr size_t WS_WKVT = WS_WUQT + 768ull * 384 * 2;
constexpr size_t WS_WQLT = WS_WKVT + 1024ull * 256 * 2;
constexpr size_t WS_WO2T = WS_WQLT + 2048ull * 384 * 2;
constexpr size_t WS_H = WS_WO2T + 1024ull * 1024 * 2;
constexpr size_t WS_O = WS_H + (size_t)MT * 1024 * 2;
constexpr size_t WS_KC = WS_O + (size_t)MT * 1024 * 2;
constexpr size_t WS_R1 = WS_KC + 32ull * 4112 * 288 * 2;
constexpr size_t R1_QKVG = 0;
constexpr size_t R1_MIXED = (size_t)MT * 3072 * 2;
constexpr size_t R1_ACT = 0;
constexpr size_t R1_IN1 = 0;
constexpr size_t R1_QF = (size_t)MT * 1792 * 2;
constexpr size_t R1_KVUP = R1_QF + (size_t)MT * 768 * 2;
constexpr size_t R1_QLAT = R1_KVUP + (size_t)MT * 1024 * 2;
constexpr size_t R1_MIXED2 = R1_QLAT + 512ull * 2048 * 2;
constexpr size_t WS_RS = WS_R1 + R1_MIXED2 + (size_t)MT * 1024 * 2;
constexpr size_t WS_END = WS_RS + (size_t)MT * 4;

struct Params {
    const float* in[27];
    float* out;
    unsigned char* ws;
};

typedef __bf16 bf2v __attribute__((ext_vector_type(2)));
DEVI unsigned short f2bf(float f) { __bf16 v = (__bf16)f; return __builtin_bit_cast(unsigned short, v); }
DEVI unsigned pk2(float a, float b) { bf2v v = {(__bf16)a, (__bf16)b}; return __builtin_bit_cast(unsigned, v); }
DEVI float bflo(unsigned w) { return __uint_as_float(w << 16); }
DEVI float bfhi(unsigned w) { return __uint_as_float(w & 0xffff0000u); }
DEVI float bf2f(unsigned short h) { return __uint_as_float(((unsigned)h) << 16); }
DEVI float wave_sum(float v) {
#pragma unroll
    for (int o = 32; o > 0; o >>= 1) v += __shfl_xor(v, o);
    return v;
}
DEVI void unpack8(u32x4 w, float* f) {
    f[0] = bflo(w.x); f[1] = bfhi(w.x); f[2] = bflo(w.y); f[3] = bfhi(w.y);
    f[4] = bflo(w.z); f[5] = bfhi(w.z); f[6] = bflo(w.w); f[7] = bfhi(w.w);
}
DEVI u32x4 pack8(const float* f) { u32x4 w; w.x = pk2(f[0], f[1]); w.y = pk2(f[2], f[3]); w.z = pk2(f[4], f[5]); w.w = pk2(f[6], f[7]); return w; }
DEVI int get_tid() { int t = threadIdx.x; asm volatile("" : "+v"(t)); return t; }
DEVI int row_pos(int row) { return row < NP ? (row & 2047) : 4096 + ((row - NP) & 15); }

constexpr int BM = 256, BK = 64, HALF = 128, HT = HALF * BK;
DEVI int lds_byte(int r, int c) {
    int st = (r >> 4) * 2 + (c >> 5), rr = r & 15, cc = c & 31, ob = rr * 64 + cc * 2;
    return st * 1024 + (ob ^ (((ob >> 9) & 1) << 5));
}
DEVI void stage_rc(int b, int& R, int& C) {
    int st = b / 1024, sb = b % 1024, swz = sb ^ (((sb >> 9) & 1) << 5);
    R = (st >> 1) * 16 + swz / 64; C = (st & 1) * 32 + (swz % 64) / 2;
}

#define LAS __attribute__((address_space(3)))
template <int NSTORE, class TF, class F>
DEVI void gemm_run(const bf16_t* __restrict__ A, int lda, const bf16_t* __restrict__ Bt, int ldb, int K, bf16_t* shm, TF&& tile, F&& emit) {
    LAS unsigned char* lds = (LAS unsigned char*)shm;
    const int tid = get_tid(), wid = __builtin_amdgcn_readfirstlane(tid >> 6), lane = tid & 63, wr = wid >> 2, wc = wid & 3, fr = lane & 15, fq = lane >> 4;
    const int nt = K / BK;
    unsigned voffA[2], voffB[2];
#pragma unroll
    for (int i = 0; i < 2; ++i) { int R, C; stage_rc(tid * 16 + i * 8192, R, C); const int rho = R & 31; const int Rb = (R & ~31) + (8 * ((rho & 15) >> 2) + 4 * (rho >> 4) + (rho & 3));
        voffA[i] = (unsigned)(R * lda + C) * 2u; voffB[i] = (unsigned)(Rb * ldb + C) * 2u; }
    const size_t kstep = (size_t)(BK * 2);
    const size_t hstepA = (size_t)HALF * lda * 2, hstepB = (size_t)HALF * ldb * 2;
    const unsigned ldsw = (unsigned)wid * 1024u;
    const int aoff = lds_byte(wr * 64 + fr, fq * 8), boff = lds_byte(wc * 32 + fr, fq * 8);
    constexpr int HTB = HALF * BK * 2;
#define G_SA(b, h) (((b) * 2 + (h)) * HTB)
#define G_SB(b, h) ((4 + (b) * 2 + (h)) * HTB)
#define G_STAGE(bufoff, gbase, voff) do { _Pragma("unroll") for (int _i = 0; _i < 2; ++_i) \
        __builtin_amdgcn_global_load_lds((const unsigned*)((const char*)(gbase) + (voff)[_i]), (LAS unsigned*)(lds + (bufoff) + ldsw + _i * 8192), 16, 0, 0); } while (0)
#define G_LDA(dst, b, h) do { _Pragma("unroll") for (int m = 0; m < 4; ++m) _Pragma("unroll") for (int k = 0; k < 2; ++k) dst[m][k] = *(const LAS bf16x8*)(lds + G_SA(b, h) + aoff + m * 2048 + k * 1024); } while (0)
#define G_LDB(dst, b, h) do { _Pragma("unroll") for (int n = 0; n < 2; ++n) _Pragma("unroll") for (int k = 0; k < 2; ++k) dst[n][k] = *(const LAS bf16x8*)(lds + G_SB(b, h) + boff + n * 2048 + k * 1024); } while (0)
#define G_MMA(ai, bj, At, Bt_) do { __builtin_amdgcn_s_setprio(1); _Pragma("unroll") for (int m = 0; m < 4; ++m) _Pragma("unroll") for (int n = 0; n < 2; ++n) _Pragma("unroll") for (int k = 0; k < 2; ++k) \
        acc[ai][bj][m][n] = __builtin_amdgcn_mfma_f32_16x16x32_bf16(Bt_[n][k], At[m][k], acc[ai][bj][m][n], 0, 0, 0); __builtin_amdgcn_s_setprio(0); } while (0)
#define G_WAIT_V(n) asm volatile("s_waitcnt vmcnt(" #n ")" ::: "memory")
#define G_WAIT_L(n) asm volatile("s_waitcnt lgkmcnt(" #n ")" ::: "memory")
#define G_BAR __builtin_amdgcn_s_barrier()
#define G_SCHED __builtin_amdgcn_sched_barrier(0)
    int brow, bcol, nrow, ncol; int ui = 0;
    if (!tile(0, brow, bcol)) return;
    f32x4 acc[2][2][4][2];
#pragma unroll
    for (int a = 0; a < 2; ++a)
#pragma unroll
        for (int b = 0; b < 2; ++b)
#pragma unroll
            for (int m = 0; m < 4; ++m)
#pragma unroll
                for (int n = 0; n < 2; ++n) acc[a][b][m][n] = (f32x4){0.f, 0.f, 0.f, 0.f};
    bf16x8 At[4][2], B0[2][2], B1[2][2];
    const char* cA = (const char*)A + (size_t)brow * lda * 2; const char* cB = (const char*)Bt + (size_t)bcol * ldb * 2;
    G_STAGE(G_SB(0, 0), cB, voffB); G_STAGE(G_SB(0, 1), cB + hstepB, voffB); G_STAGE(G_SA(0, 0), cA, voffA); G_STAGE(G_SA(0, 1), cA + hstepA, voffA);
    if (wr == 1) G_BAR;
    G_WAIT_V(2); G_BAR;
    G_STAGE(G_SB(1, 0), cB + kstep, voffB); G_STAGE(G_SA(1, 0), cA + kstep, voffA); G_STAGE(G_SB(1, 1), cB + hstepB + kstep, voffB);
    G_WAIT_V(6); G_BAR;
    for (;;) {
        const bool has_next = tile(ui + 1, nrow, ncol);
        const char* nA = has_next ? (const char*)A + (size_t)nrow * lda * 2 : cA; const char* nB = has_next ? (const char*)Bt + (size_t)ncol * ldb * 2 : cB;
        for (int t = 0; t < nt; t += 2) {
            const bool last = (t == nt - 2);
            const char* a1 = cA + (size_t)(t + 1) * kstep;
            const char* a2 = last ? nA : cA + (size_t)(t + 2) * kstep; const char* b2 = last ? nB : cB + (size_t)(t + 2) * kstep;
            const char* a3 = a2 + kstep; const char* b3 = b2 + kstep;
            G_LDB(B0, 0, 0); G_LDB(B1, 0, 1); G_SCHED; G_LDA(At, 0, 0); G_STAGE(G_SA(1, 1), a1 + hstepA, voffA);
            G_WAIT_V(8); G_WAIT_L(0); G_BAR; G_MMA(0, 0, At, B0); G_MMA(0, 1, At, B1); G_BAR; G_SCHED;
            G_LDA(At, 0, 1); G_STAGE(G_SB(0, 0), b2, voffB); G_STAGE(G_SB(0, 1), b2 + hstepB, voffB); G_STAGE(G_SA(0, 0), a2, voffA);
            G_WAIT_V(8); G_WAIT_L(0); G_BAR; G_MMA(1, 0, At, B0); G_MMA(1, 1, At, B1); G_BAR; G_SCHED;
            G_LDB(B0, 1, 0); G_LDB(B1, 1, 1); G_SCHED; G_LDA(At, 1, 0); G_STAGE(G_SA(0, 1), a2 + hstepA, voffA);
            G_WAIT_V(8); G_WAIT_L(0); G_BAR; G_MMA(0, 0, At, B0); G_MMA(0, 1, At, B1); G_BAR; G_SCHED;
            G_LDA(At, 1, 1); G_STAGE(G_SB(1, 0), b3, voffB); G_STAGE(G_SB(1, 1), b3 + hstepB, voffB); G_STAGE(G_SA(1, 0), a3, voffA);
            G_WAIT_V(8); G_WAIT_L(0); G_BAR; G_MMA(1, 0, At, B0); G_MMA(1, 1, At, B1); G_BAR; G_SCHED;
        }
        if (NSTORE != 0 && wr == 0) G_BAR;
#pragma unroll
        for (int ai = 0; ai < 2; ++ai)
#pragma unroll
            for (int m = 0; m < 4; ++m)
#pragma unroll
                for (int bj = 0; bj < 2; ++bj)
                    emit(brow + ai * HALF + wr * 64 + m * 16 + fr, bcol + bj * HALF + wc * 32 + fq * 8, acc[ai][bj][m][0], acc[ai][bj][m][1]);
        if (!has_next) break;
#pragma unroll
        for (int a = 0; a < 2; ++a)
#pragma unroll
            for (int b = 0; b < 2; ++b)
#pragma unroll
                for (int m = 0; m < 4; ++m)
#pragma unroll
                    for (int n = 0; n < 2; ++n) acc[a][b][m][n] = (f32x4){0.f, 0.f, 0.f, 0.f};
        brow = nrow; bcol = ncol; cA = nA; cB = nB; ++ui;
        if (NSTORE != 0 && wr == 1) G_BAR;
    }
    G_WAIT_V(0);
    if (NSTORE == 0 && wr == 0) G_BAR;
    G_BAR;
#undef G_SA
#undef G_SB
#undef G_STAGE
#undef G_LDA
#undef G_LDB
#undef G_MMA
}

DEVI void tile_map(int L, int nM, int nN, int& pm, int& pn) {
    const int nwg = nM * nN;
    int wgid = L;
    { const int q = nwg / 8, r = nwg % 8, xcd = wgid % 8, off = wgid / 8; wgid = (xcd < r ? xcd * (q + 1) : r * (q + 1) + (xcd - r) * q) + off; }
    const int nig = 8 * nN, gid = wgid / nig, fm = gid * 8, gsz = (nM - fm) < 8 ? (nM - fm) : 8;
    pm = fm + ((wgid % nig) % gsz); pn = (wgid % nig) / gsz;
}

template <int KW, class F>
DEVI void gemm_small(const bf16_t* __restrict__ A, int lda, const bf16_t* __restrict__ Bt, int ldb, int K, int row0, int col0, float* lds, F&& emit) {
    constexpr int RW = 8 / KW, MT16 = 4 / RW;
    const int tid = get_tid(), wv = tid >> 6, lane = tid & 63, fr = lane & 15, fq = lane >> 4;
    const int kq = wv % KW, rh = wv / KW;
    const int ks = K / KW, kbeg = kq * ks;
    f32x4 acc[MT16][4];
#pragma unroll
    for (int m = 0; m < MT16; ++m)
#pragma unroll
        for (int n = 0; n < 4; ++n) acc[m][n] = (f32x4){0.f, 0.f, 0.f, 0.f};
    const bf16_t* ap = A + (size_t)(row0 + rh * (64 / RW) + fr) * lda + kbeg + 8 * fq;
    const bf16_t* bp = Bt + (size_t)(col0 + 8 * (fr >> 2) + (fr & 3)) * ldb + kbeg + 8 * fq;
#pragma unroll 4
    for (int k = 0; k < ks; k += 32) {
        bf16x8 af[MT16], bfr[4];
#pragma unroll
        for (int m = 0; m < MT16; ++m) af[m] = *(const bf16x8*)(ap + (size_t)(m * 16) * lda + k);
#pragma unroll
        for (int n = 0; n < 4; ++n) bfr[n] = *(const bf16x8*)(bp + (size_t)((n >> 1) * 32 + (n & 1) * 4) * ldb + k);
#pragma unroll
        for (int m = 0; m < MT16; ++m)
#pragma unroll
            for (int n = 0; n < 4; ++n) acc[m][n] = __builtin_amdgcn_mfma_f32_16x16x32_bf16(bfr[n], af[m], acc[m][n], 0, 0, 0);
    }
    __syncthreads();
    float* slab = lds + kq * 4096;
#pragma unroll
    for (int m = 0; m < MT16; ++m)
#pragma unroll
        for (int n = 0; n < 4; ++n) {
            const int row = rh * (64 / RW) + m * 16 + fr, grp = ((n >> 1) * 8 + 2 * fq + (n & 1)) ^ (row & 15);
            *(f32x4*)(slab + row * 64 + grp * 4) = acc[m][n];
        }
    __syncthreads();
    {
        const int row = tid >> 3, c = tid & 7, g0 = c * 2, g1 = g0 + 1;
        f32x4 v0 = {0.f, 0.f, 0.f, 0.f}, v1 = {0.f, 0.f, 0.f, 0.f};
#pragma unroll
        for (int w = 0; w < KW; ++w) {
            v0 += *(const f32x4*)(lds + w * 4096 + row * 64 + ((g0 ^ (row & 15)) * 4));
            v1 += *(const f32x4*)(lds + w * 4096 + row * 64 + ((g1 ^ (row & 15)) * 4));
        }
        emit(row0 + row, col0 + g0 * 4, v0, v1);
    }
    __syncthreads();
}

DEVI void st_bf16x8(bf16_t* p, f32x4 a, f32x4 b) { u32x4 w; w.x = pk2(a[0], a[1]); w.y = pk2(a[2], a[3]); w.z = pk2(b[0], b[1]); w.w = pk2(b[2], b[3]); *(u32x4*)p = w; }

struct TJob { const float* src; bf16_t* dst; int K, N, Npad, src_ld; float scale; int scale_cols; const float* kgain; };
DEVI bool get_tjob(const Params& p, int j, TJob& t) {
    unsigned char* ws = p.ws;
    switch (j) {
    case 0: t = {p.in[11], (bf16_t*)(ws + WS_W1T), 1024, 3072, 3072, 3072, SBQ, 512, p.in[7]}; return true;
    case 1: t = {p.in[13], (bf16_t*)(ws + WS_WO1T), 1024, 1024, 1024, 1024, 1.f, 0, nullptr}; return true;
    case 2: t = {p.in[25], (bf16_t*)(ws + WS_WUP0), 1024, 4096, 4096, 4096, 1.f, 0, p.in[9]}; return true;
    case 3: t = {p.in[25] + 1024ull * 4096, (bf16_t*)(ws + WS_WUP1), 1024, 4096, 4096, 4096, 1.f, 0, p.in[9] + 1024}; return true;
    case 4: t = {p.in[26], (bf16_t*)(ws + WS_WDN0), 4096, 1024, 1024, 1024, 1.f, 0, nullptr}; return true;
    case 5: t = {p.in[26] + 1024ull * 4096, (bf16_t*)(ws + WS_WDN1), 4096, 1024, 1024, 1024, 1.f, 0, nullptr}; return true;
    case 6: t = {p.in[14], (bf16_t*)(ws + WS_W2T), 1024, 1696, 1792, 1696, 1.f, 0, p.in[7] + 1024}; return true;
    case 7: t = {p.in[21], (bf16_t*)(ws + WS_WUQT), 384, 768, 768, 768, MLQ, 768, nullptr}; return true;
    case 8: t = {p.in[24], (bf16_t*)(ws + WS_WO2T), 1024, 1024, 1024, 1024, 1.f, 0, nullptr}; return true;
    default:
        if (j < 17) { int h = j - 9; t = {p.in[23] + (size_t)h * 256 * 64, (bf16_t*)(ws + WS_WKVT) + (size_t)(512 + h * 64) * 256, 256, 64, 64, 64, 1.f, 0, nullptr}; return true; }
        return false;
    }
}

DEVI void phase_prep(const Params& p, float* lds) {
    const int tid = get_tid();
    int base = 0;
    for (int j = 0; j < 17; ++j) {
        TJob t; get_tjob(p, j, t);
        const int tk = t.K / 64, tn = t.Npad / 64, ntile = tk * tn;
        int first = ((int)blockIdx.x - base % (int)gridDim.x + (int)gridDim.x) % (int)gridDim.x;
        for (int i = first; i < ntile; i += gridDim.x) {
            const int k0 = (i % tk) * 64, n0 = (i / tk) * 64;
            __syncthreads();
#pragma unroll
            for (int e = 0; e < 2; ++e) {
                const int idx = tid + e * 512, kk = idx >> 4, n4 = (idx & 15) * 4, n = n0 + n4;
                f32x4 v = {0.f, 0.f, 0.f, 0.f};
                if (n < t.N) { v = *(const f32x4*)(t.src + (size_t)(k0 + kk) * t.src_ld + n); if (n < t.scale_cols) v = v * t.scale; if (t.kgain) v = v * t.kgain[k0 + kk]; }
                lds[kk * 65 + n4] = v[0]; lds[kk * 65 + n4 + 1] = v[1]; lds[kk * 65 + n4 + 2] = v[2]; lds[kk * 65 + n4 + 3] = v[3];
            }
            __syncthreads();
            {
                const int nn = tid >> 3, kc = tid & 7;
                float o[8];
#pragma unroll
                for (int j = 0; j < 8; ++j) o[j] = lds[(kc * 8 + j) * 65 + nn];
                *(u32x4*)(t.dst + (size_t)(n0 + nn) * t.K + k0 + kc * 8) = pack8(o);
            }
        }
        base += ntile;
    }
    const int gtid = blockIdx.x * 512 + tid, gsz = gridDim.x * 512;
    {
        bf16_t* dst = (bf16_t*)(p.ws + WS_WKVT);
        const float* src = p.in[22];
        for (int i = gtid; i < 512 * 256; i += gsz) dst[i] = f2bf(src[i]);
    }
    {
        bf16_t* dst = (bf16_t*)(p.ws + WS_WQLT);
        const float* wuq = p.in[21];
        const float* wuk = p.in[22];
        for (int i = gtid; i < 2048 * 384; i += gsz) {
            int c = i & 255, h = (i >> 8) & 7, j = i >> 11;
            const float* a = wuq + (size_t)j * 768 + h * 96;
            const float* b = wuk + (size_t)h * 64 * 256 + c;
            float s = 0.f;
#pragma unroll 8
            for (int n = 0; n < 64; ++n) s += a[n] * b[(size_t)n * 256];
            dst[(size_t)(h * 256 + c) * 384 + j] = f2bf(s * MLQ);
        }
    }
    {
        const int wv = tid >> 6, lane = tid & 63;
        bf16_t* X = (bf16_t*)(p.ws + WS_H);
        float* RS = (float*)(p.ws + WS_RS);
        for (int rowb = (blockIdx.x * 8 + wv) * 2; rowb < MT; rowb += gridDim.x * 16) {
            float v[2][16]; float ss[2] = {0.f, 0.f};
#pragma unroll
            for (int rr = 0; rr < 2; ++rr) {
                const int row = rowb + rr;
                const float* x = row < NP ? p.in[0] + (size_t)row * 1024 : p.in[1] + (size_t)(row - NP) * 1024;
#pragma unroll
                for (int i = 0; i < 2; ++i) {
                    f32x4 a = *(const f32x4*)(x + i * 512 + lane * 8), b = *(const f32x4*)(x + i * 512 + lane * 8 + 4);
#pragma unroll
                    for (int k = 0; k < 4; ++k) { v[rr][i * 8 + k] = a[k]; v[rr][i * 8 + 4 + k] = b[k]; }
                }
            }
#pragma unroll
            for (int rr = 0; rr < 2; ++rr)
#pragma unroll
                for (int k = 0; k < 16; ++k) ss[rr] += v[rr][k] * v[rr][k];
#pragma unroll
            for (int of = 32; of > 0; of >>= 1) { ss[0] += __shfl_xor(ss[0], of); ss[1] += __shfl_xor(ss[1], of); }
#pragma unroll
            for (int rr = 0; rr < 2; ++rr) {
                const float r = rsqrtf(ss[rr] * (1.f / 1024.f) + EPS);
#pragma unroll
                for (int k = 0; k < 16; ++k) v[rr][k] *= r;
#pragma unroll
                for (int i = 0; i < 2; ++i) *(u32x4*)(X + (size_t)(rowb + rr) * 1024 + i * 512 + lane * 8) = pack8(v[rr] + i * 8);
                if (lane == 0) RS[rowb + rr] = r;
            }
        }
    }
}

DEVI void phase_rowpass(const Params& p, bool first, const float* g1, bool final_) {
    const int tid = get_tid(), wv = tid >> 6, lane = tid & 63;
    const bf16_t* O = (const bf16_t*)(p.ws + WS_O);
    bf16_t* X = (bf16_t*)(p.ws + WS_H);
    float* RS = (float*)(p.ws + WS_RS);
    float ga[16];
#pragma unroll
    for (int i = 0; i < 2; ++i)
#pragma unroll
        for (int k = 0; k < 8; ++k) ga[i * 8 + k] = g1[i * 512 + lane * 8 + k];
    for (int rowb = (blockIdx.x * 8 + wv) * 2; rowb < MT; rowb += gridDim.x * 16) {
        float o[2][16], x[2][16];
#pragma unroll
        for (int rr = 0; rr < 2; ++rr) {
            const int row = rowb + rr;
#pragma unroll
            for (int i = 0; i < 2; ++i) {
                unpack8(*(const u32x4*)(O + (size_t)row * 1024 + i * 512 + lane * 8), o[rr] + i * 8);
                if (first) {
                    const float* xin = row < NP ? p.in[0] + (size_t)row * 1024 : p.in[1] + (size_t)(row - NP) * 1024;
                    f32x4 a = *(const f32x4*)(xin + i * 512 + lane * 8), b = *(const f32x4*)(xin + i * 512 + lane * 8 + 4);
#pragma unroll
                    for (int k = 0; k < 4; ++k) { x[rr][i * 8 + k] = a[k]; x[rr][i * 8 + 4 + k] = b[k]; }
                } else unpack8(*(const u32x4*)(X + (size_t)row * 1024 + i * 512 + lane * 8), x[rr] + i * 8);
            }
            if (!first) {
                const float inv = 1.f / RS[row];
#pragma unroll
                for (int k = 0; k < 16; ++k) x[rr][k] *= inv;
            }
        }
        float ss[2] = {0.f, 0.f};
#pragma unroll
        for (int rr = 0; rr < 2; ++rr)
#pragma unroll
            for (int k = 0; k < 16; ++k) ss[rr] += o[rr][k] * o[rr][k];
#pragma unroll
        for (int of = 32; of > 0; of >>= 1) { ss[0] += __shfl_xor(ss[0], of); ss[1] += __shfl_xor(ss[1], of); }
        float s2[2] = {0.f, 0.f};
#pragma unroll
        for (int rr = 0; rr < 2; ++rr) {
            const float r = rsqrtf(ss[rr] * (1.f / 1024.f) + EPS);
#pragma unroll
            for (int k = 0; k < 16; ++k) { float v = x[rr][k] + o[rr][k] * r * ga[k]; x[rr][k] = v; s2[rr] += v * v; }
        }
        if (final_) {
#pragma unroll
            for (int rr = 0; rr < 2; ++rr) {
                float* y = p.out + O_Y + (size_t)(rowb + rr) * 1024;
#pragma unroll
                for (int i = 0; i < 2; ++i) {
                    *(f32x4*)(y + i * 512 + lane * 8) = (f32x4){x[rr][i * 8], x[rr][i * 8 + 1], x[rr][i * 8 + 2], x[rr][i * 8 + 3]};
                    *(f32x4*)(y + i * 512 + lane * 8 + 4) = (f32x4){x[rr][i * 8 + 4], x[rr][i * 8 + 5], x[rr][i * 8 + 6], x[rr][i * 8 + 7]};
                }
            }
        } else {
#pragma unroll
            for (int of = 32; of > 0; of >>= 1) { s2[0] += __shfl_xor(s2[0], of); s2[1] += __shfl_xor(s2[1], of); }
#pragma unroll
            for (int rr = 0; rr < 2; ++rr) {
                const float r2 = rsqrtf(s2[rr] * (1.f / 1024.f) + EPS);
#pragma unroll
                for (int k = 0; k < 16; ++k) x[rr][k] *= r2;
#pragma unroll
                for (int i = 0; i < 2; ++i) *(u32x4*)(X + (size_t)(rowb + rr) * 1024 + i * 512 + lane * 8) = pack8(x[rr] + i * 8);
                if (lane == 0) RS[rowb + rr] = r2;
            }
        }
    }
}

DEVI void rope_consts(int i, float& crev) { crev = __builtin_amdgcn_exp2f(-(float)i * (13.287712379549449f / 16.f)) * 0.15915494309189535f; }
DEVI void rope_sc(int pos, float crev, float& s, float& c) { float rev = (float)pos * crev; rev -= floorf(rev); s = __builtin_amdgcn_sinf(rev); c = __builtin_amdgcn_cosf(rev); }

DEVI void phase_l1rows(const Params& p) {
    const int tid = get_tid(), wv = tid >> 6, lane = tid & 63;
    bf16_t* IN1 = (bf16_t*)(p.ws + WS_R1 + R1_IN1);
    bf16_t* KC = (bf16_t*)(p.ws + WS_KC);
    const float* lng = p.in[15]; const float* lnb = p.in[16]; const float* qg = p.in[19]; const float* kvg = p.in[20];
    float crev; rope_consts(lane & 15, crev);
    float glng[8], glnb[8], gq[8], gkv[8];
#pragma unroll
    for (int k = 0; k < 8; ++k) { glng[k] = lng[lane * 8 + k]; glnb[k] = lnb[lane * 8 + k]; gq[k] = lane < 48 ? qg[lane * 8 + k] : 0.f; gkv[k] = lane < 32 ? kvg[lane * 8 + k] : 0.f; }
    for (int rowb = (blockIdx.x * 8 + wv) * 2; rowb < MT; rowb += gridDim.x * 16) {
        float v[2][8], cq[2][8], kv[2][8], x1[2], x2[2];
#pragma unroll
        for (int rr = 0; rr < 2; ++rr) {
            const bf16_t* r = IN1 + (size_t)(rowb + rr) * 1792;
            unpack8(*(const u32x4*)(r + 512 + lane * 8), v[rr]);
            u32x4 z = {0u, 0u, 0u, 0u};
            unpack8(lane < 48 ? *(const u32x4*)(r + 1024 + lane * 8) : z, cq[rr]);
            unpack8(lane < 32 ? *(const u32x4*)(r + 1408 + lane * 8) : z, kv[rr]);
            x1[rr] = lane < 16 ? bf2f(r[1664 + lane]) : 0.f; x2[rr] = lane < 16 ? bf2f(r[1680 + lane]) : 0.f;
        }
        float sv[2], sq[2], sk[2];
#pragma unroll
        for (int rr = 0; rr < 2; ++rr) {
            sv[rr] = 0.f; sq[rr] = 0.f; sk[rr] = 0.f;
#pragma unroll
            for (int k = 0; k < 8; ++k) { sv[rr] += v[rr][k]; sq[rr] += cq[rr][k] * cq[rr][k]; sk[rr] += kv[rr][k] * kv[rr][k]; }
        }
#pragma unroll
        for (int of = 32; of > 0; of >>= 1)
#pragma unroll
            for (int rr = 0; rr < 2; ++rr) { sv[rr] += __shfl_xor(sv[rr], of); sq[rr] += __shfl_xor(sq[rr], of); sk[rr] += __shfl_xor(sk[rr], of); }
        float var[2];
#pragma unroll
        for (int rr = 0; rr < 2; ++rr) {
            const float mu = sv[rr] * (1.f / 512.f); var[rr] = 0.f;
#pragma unroll
            for (int k = 0; k < 8; ++k) { v[rr][k] -= mu; var[rr] += v[rr][k] * v[rr][k]; }
        }
#pragma unroll
        for (int of = 32; of > 0; of >>= 1) { var[0] += __shfl_xor(var[0], of); var[1] += __shfl_xor(var[1], of); }
#pragma unroll
        for (int rr = 0; rr < 2; ++rr) {
            const int row = rowb + rr;
            bf16_t* r = IN1 + (size_t)row * 1792;
            {
                const float rs = rsqrtf(var[rr] * (1.f / 512.f) + EPS);
#pragma unroll
                for (int k = 0; k < 8; ++k) v[rr][k] = v[rr][k] * rs * glng[k] + glnb[k];
                *(u32x4*)(r + 512 + lane * 8) = pack8(v[rr]);
                if (row >= NP) {
                    float* o = p.out + O_SGUV_S + (size_t)(row - NP) * 512 + lane * 8;
                    *(f32x4*)o = (f32x4){v[rr][0], v[rr][1], v[rr][2], v[rr][3]}; *(f32x4*)(o + 4) = (f32x4){v[rr][4], v[rr][5], v[rr][6], v[rr][7]};
                }
            }
            if (lane < 48) {
                const float rs = rsqrtf(sq[rr] * (1.f / 384.f) + EPS);
#pragma unroll
                for (int k = 0; k < 8; ++k) cq[rr][k] = cq[rr][k] * rs * gq[k];
                *(u32x4*)(r + 1024 + lane * 8) = pack8(cq[rr]);
            }
            if (lane < 32) {
                const float rs = rsqrtf(sk[rr] * (1.f / 256.f) + EPS);
#pragma unroll
                for (int k = 0; k < 8; ++k) kv[rr][k] = kv[rr][k] * rs * gkv[k];
                u32x4 w = pack8(kv[rr]);
                *(u32x4*)(r + 1408 + lane * 8) = w;
                float* o = row < NP ? p.out + O_CKV_P + (size_t)row * 256 + lane * 8 : p.out + O_CKV_S + (size_t)(row - NP) * 256 + lane * 8;
                *(f32x4*)o = (f32x4){kv[rr][0], kv[rr][1], kv[rr][2], kv[rr][3]}; *(f32x4*)(o + 4) = (f32x4){kv[rr][4], kv[rr][5], kv[rr][6], kv[rr][7]};
                if (row >= NP) { int b = (row - NP) >> 4, t = (row - NP) & 15; *(u32x4*)(KC + ((size_t)b * 4112 + 4096 + t) * 288 + lane * 8) = w; }
            }
            if (lane < 16) {
                float sn, c; rope_sc(row_pos(row), crev, sn, c);
                float o1 = x1[rr] * c - x2[rr] * sn, o2 = x1[rr] * sn + x2[rr] * c;
                bf16_t b1 = f2bf(o1), b2 = f2bf(o2);
                r[1664 + lane] = b1; r[1680 + lane] = b2;
                float* o = row < NP ? p.out + O_KPE_P + (size_t)row * 32 : p.out + O_KPE_S + (size_t)(row - NP) * 32;
                o[lane] = o1; o[lane + 16] = o2;
                if (row >= NP) { int b = (row - NP) >> 4, t = (row - NP) & 15; bf16_t* kc = KC + ((size_t)b * 4112 + 4096 + t) * 288 + 256; kc[lane] = b1; kc[lane + 16] = b2; }
            }
        }
    }
}

DEVI void kc_item(const Params& p, int item) {
    const int tid = get_tid();
    bf16_t* KC = (bf16_t*)(p.ws + WS_KC);
    const float* cc = p.in[5]; const float* cp = p.in[6];
#pragma unroll
    for (int e = 0; e < 8; ++e) {
        const long id = (long)item * 4096 + e * 512 + tid;
        const long rw = id / 36; const int ch = (int)(id - rw * 36);
        const int b = (int)(rw >> 12), kk = (int)(rw & 4095);
        const float* src = ch < 32 ? cc + (size_t)rw * 256 + ch * 8 : cp + (size_t)rw * 32 + (ch - 32) * 8;
        f32x4 a = *(const f32x4*)src, bb = *(const f32x4*)(src + 4);
        u32x4 w; w.x = pk2(a[0], a[1]); w.y = pk2(a[2], a[3]); w.z = pk2(bb[0], bb[1]); w.w = pk2(bb[2], bb[3]);
        *(u32x4*)(KC + ((size_t)b * 4112 + kk) * 288 + ch * 8) = w;
    }
}

DEVI void conv_item(const Params& p, int item) {
    const int tid = get_tid(), ch = tid & 63, rs = tid >> 6;
    const bf16_t* Q = (const bf16_t*)(p.ws + WS_R1 + R1_QKVG);
    bf16_t* MX = (bf16_t*)(p.ws + WS_R1 + R1_MIXED);
    const float* wc = p.in[12];
    float w0[8], w1[8], w2[8];
#pragma unroll
    for (int k = 0; k < 8; ++k) { w0[k] = wc[ch * 8 + k]; w1[k] = wc[512 + ch * 8 + k]; w2[k] = wc[1024 + ch * 8 + k]; }
#pragma unroll 1
    for (int i = 0; i < 4; ++i) {
        int rbase = item * 32;
        if (item < 2048) { const int bi = item >> 6; rbase = ((bi & 7) * 4 + (3 - (bi >> 3))) * 2048 + (item & 63) * 32; }
        const int row = rbase + rs + i * 8;
        const bool samp = row >= NP;
        const int t = samp ? (row - NP) & 15 : row & 2047;
        const int b = samp ? (row - NP) >> 4 : row >> 11;
        float cin[3][8];
#pragma unroll
        for (int j = 0; j < 3; ++j) {
            if (t - j >= 0) {
                const bf16_t* rr = Q + (size_t)(row - j) * 3072;
                float a[8], u[8]; unpack8(*(const u32x4*)(rr + 2048 + ch * 8), a); unpack8(*(const u32x4*)(rr + 2560 + ch * 8), u);
#pragma unroll
                for (int k = 0; k < 8; ++k) cin[j][k] = a[k] * u[k];
            } else if (samp) {
                const float* pv = p.in[4] + ((size_t)b * 2 + (2 + t - j)) * 512 + ch * 8;
#pragma unroll
                for (int k = 0; k < 8; ++k) cin[j][k] = pv[k];
            } else {
#pragma unroll
                for (int k = 0; k < 8; ++k) cin[j][k] = 0.f;
            }
        }
        {
            float kf[8], vf[8];
            unpack8(*(const u32x4*)(Q + (size_t)row * 3072 + 512 + ch * 8), kf); unpack8(*(const u32x4*)(Q + (size_t)row * 3072 + 1024 + ch * 8), vf);
            float* ok = p.out + (samp ? O_SBK_S + (size_t)(row - NP) * 512 : O_SBK_P + (size_t)row * 512) + ch * 8;
            float* ov = p.out + (samp ? O_SBV_S + (size_t)(row - NP) * 512 : O_SBV_P + (size_t)row * 512) + ch * 8;
            *(f32x4*)ok = (f32x4){kf[0], kf[1], kf[2], kf[3]}; *(f32x4*)(ok + 4) = (f32x4){kf[4], kf[5], kf[6], kf[7]};
            *(f32x4*)ov = (f32x4){vf[0], vf[1], vf[2], vf[3]}; *(f32x4*)(ov + 4) = (f32x4){vf[4], vf[5], vf[6], vf[7]};
        }
        float gp[8]; unpack8(*(const u32x4*)(Q + (size_t)row * 3072 + 1536 + ch * 8), gp);
        float o[8];
#pragma unroll
        for (int k = 0; k < 8; ++k) o[k] = gp[k] * (w0[k] * cin[2][k] + w1[k] * cin[1][k] + w2[k] * cin[0][k]);
        *(u32x4*)(MX + (size_t)row * 1024 + 512 + ch * 8) = pack8(o);
        const int tl = samp ? 14 : 2046;
        if (t >= tl) {
            float* o2 = p.out + (samp ? O_CONV_S : O_CONV_P) + ((size_t)b * 2 + (t - tl)) * 512 + ch * 8;
#pragma unroll
            for (int k = 0; k < 8; ++k) o2[k] = cin[0][k];
        }
    }
}

DEVI s4v tr_read(const unsigned char* lp) { return __builtin_amdgcn_ds_read_tr16_b64_v4i16((__attribute__((address_space(3))) s4v*)(lp)); }

DEVI void sgu_item(const Params& p, int sg, unsigned char* smem) {
    const int tid = get_tid(), wv = tid >> 6, lane = tid & 63;
    int g, row0, L;
    if (sg < 2048) { const int chunk = sg >> 2; g = sg & 3; row0 = (chunk >> 4) * 2048 + (chunk & 15) * 128; L = 128; }
    else { const int s2 = sg - 2048; g = s2 & 3; row0 = NP + (s2 >> 2) * 16; L = 16; }
    bf16_t* IN1 = (bf16_t*)(p.ws + WS_R1 + R1_IN1);
    bf16_t* MX = (bf16_t*)(p.ws + WS_R1 + R1_MIXED2);
    const float* Wg = p.in[17] + (size_t)g * 128 * 128;
    const float* bs = p.in[18] + g * 128;
    constexpr int STR = 272;
    unsigned char* Wl = smem; unsigned char* Vl = smem + 128 * STR;
#pragma unroll
    for (int e = 0; e < 8; ++e) {
        int idx = tid + e * 512, t = idx >> 5, s4 = (idx & 31) * 4;
        f32x4 w = {0.f, 0.f, 0.f, 0.f};
        if (t < L) w = *(const f32x4*)(Wg + t * 128 + s4);
        float o[4];
#pragma unroll
        for (int k = 0; k < 4; ++k) o[k] = (s4 + k <= t && s4 + k < L) ? w[k] : 0.f;
        u32x2 pw; pw.x = pk2(o[0], o[1]); pw.y = pk2(o[2], o[3]);
        *(u32x2*)(Wl + t * STR + s4 * 2) = pw;
    }
#pragma unroll
    for (int e = 0; e < 4; ++e) {
        int idx = tid + e * 512, s = idx >> 4, c = idx & 15;
        u32x4 w = {0u, 0u, 0u, 0u};
        if (s < L) w = *(const u32x4*)(IN1 + (size_t)(row0 + s) * 1792 + 512 + g * 128 + c * 8);
        *(u32x4*)(Vl + s * STR + c * 16) = w;
    }
    __syncthreads();
    const int tb = wv >> 1, r = lane & 31, h = lane >> 5, grp = lane >> 4, q = (lane & 15) >> 2, pp = lane & 3;
    f32x16 acc[2] = {};
    if (tb * 32 < L) {
        for (int sb = 0; sb <= tb; ++sb) {
#pragma unroll
            for (int st = 0; st < 2; ++st) {
                bf16x8 a = *(const bf16x8*)(Wl + (tb * 32 + r) * STR + (sb * 32 + st * 16 + 8 * h) * 2);
#pragma unroll
                for (int d2 = 0; d2 < 2; ++d2) {
                    const int db = (wv & 1) * 2 + d2;
                    const unsigned char* vp = Vl + (sb * 32 + st * 16 + 8 * h + q) * STR + (db * 32 + 16 * (grp & 1) + 4 * pp) * 2;
                    s4v lo = tr_read(vp), hi = tr_read(vp + 4 * STR);
                    bf16x8 bfr = __builtin_shufflevector(lo, hi, 0, 1, 2, 3, 4, 5, 6, 7);
                    acc[d2] = __builtin_amdgcn_mfma_f32_32x32x16_bf16(a, bfr, acc[d2], 0, 0, 0);
                }
            }
        }
    }
    __syncthreads();
    float* Sl = (float*)smem;
    if (tb * 32 < L) {
#pragma unroll
        for (int d2 = 0; d2 < 2; ++d2) {
            const int d = ((wv & 1) * 2 + d2) * 32 + r;
#pragma unroll
            for (int reg = 0; reg < 16; ++reg) {
                const int t = tb * 32 + (reg & 3) + 8 * (reg >> 2) + 4 * h;
                Sl[t * 132 + d] = acc[d2][reg];
            }
        }
    }
    __syncthreads();
#pragma unroll
    for (int e = 0; e < 4; ++e) {
        const int idx = tid + e * 512, t = idx >> 4, c = idx & 15;
        if (t < L) {
            float u[8]; unpack8(*(const u32x4*)(IN1 + (size_t)(row0 + t) * 1792 + g * 128 + c * 8), u);
            const f32x4 s0 = *(const f32x4*)(Sl + t * 132 + c * 8), s1 = *(const f32x4*)(Sl + t * 132 + c * 8 + 4);
            const float bt = bs[t];
            float o[8];
#pragma unroll
            for (int k = 0; k < 4; ++k) { o[k] = u[k] * (s0[k] + bt); o[4 + k] = u[4 + k] * (s1[k] + bt); }
            *(u32x4*)(MX + (size_t)(row0 + t) * 1024 + g * 128 + c * 8) = pack8(o);
        }
    }
}

template <int MODE> struct AC;
template <> struct AC<0> { static constexpr int DQK = 64, DV = 64, KSTR = 144, VSTR = 144, NST = 2; };
template <> struct AC<1> { static constexpr int DQK = 96, DV = 64, KSTR = 208, VSTR = 192, NST = 3; };
template <> struct AC<2> { static constexpr int DQK = 288, DV = 256, KSTR = 592, VSTR = 592, NST = 5; };
constexpr int SM_V = 40960, SM_FLAG = 65536;

DEVI u32x4 ld_f32x8_bf16(const float* src) {
    f32x4 a = *(const f32x4*)src, b = *(const f32x4*)(src + 4);
    u32x4 w; w.x = pk2(a[0], a[1]); w.y = pk2(a[2], a[3]); w.z = pk2(b[0], b[1]); w.w = pk2(b[2], b[3]); return w;
}

template <int MODE>
DEVI void attn_item(const Params& p, int item, unsigned char* smem) {
    typedef AC<MODE> C;
    constexpr int KS = C::DQK / 16, DB = (MODE == 2) ? 4 : C::DV / 32, NST = C::NST, NQF = (MODE == 2) ? 1 : KS;
    const int tid = get_tid(), wv = tid >> 6, lane = tid & 63;
    const int r = lane & 31, h = lane >> 5, grp = lane >> 4, q4 = (lane & 15) >> 2, pp = lane & 3;
    unsigned char* Ks = smem;
    unsigned char* Vs = (MODE == 2) ? smem : smem + SM_V;
    unsigned char* Qs = smem + SM_V;
    volatile int* flags = (volatile int*)(smem + SM_FLAG);

    int b = 0, hd = 0, q0 = 0, kt_last = 0; bool samp = false;
    if constexpr (MODE == 0) {
        if (item < 2048) { const int bi = item >> 6, qb = 7 - ((item >> 3) & 7); b = (bi & 7) * 4 + (3 - (bi >> 3)); hd = item & 7; q0 = qb * 256; kt_last = (q0 + 255) >> 6; }
        else { const int s = item - 2048; b = s >> 3; hd = s & 7; samp = true; q0 = 4096; kt_last = 64; }
    } else if constexpr (MODE == 1) {
        const int qb = 7 - (item >> 8); b = (item & 255) >> 3; hd = item & 7; q0 = qb * 256; kt_last = (q0 + 255) >> 6;
    } else { b = item; kt_last = 64; }
    const bf16_t* QKVG = (const bf16_t*)(p.ws + WS_R1 + R1_QKVG);
    const bf16_t* IN1 = (const bf16_t*)(p.ws + WS_R1 + R1_IN1);
    const bf16_t* QF = (const bf16_t*)(p.ws + WS_R1 + R1_QF);
    const bf16_t* KVUP = (const bf16_t*)(p.ws + WS_R1 + R1_KVUP);
    const bf16_t* QLAT = (const bf16_t*)(p.ws + WS_R1 + R1_QLAT);
    const bf16_t* KC = (const bf16_t*)(p.ws + WS_KC);

    bool wactive; int qpos = 0; bool qvalid = true; size_t orow = 0;
    bf16x8 qf[NQF];
    const int rg = wv & 3, dvh = (MODE == 2) ? (wv >> 2) : 0;
    if constexpr (MODE == 0) {
        wactive = samp ? (wv == 0) : true;
        int qi = samp ? (r & 15) : (wv * 32 + r);
        qvalid = samp ? (r < 16) : true;
        qpos = q0 + qi;
        orow = samp ? (size_t)(NP + b * 16 + qi) : (size_t)(b * 2048 + q0 + qi);
        const bf16_t* qp = QKVG + orow * 3072 + hd * 64;
#pragma unroll
        for (int st = 0; st < KS; ++st) qf[st] = *(const bf16x8*)(qp + st * 16 + 8 * h);
    } else if constexpr (MODE == 1) {
        wactive = true; qpos = q0 + wv * 32 + r; orow = (size_t)(b * 2048 + qpos);
        const bf16_t* qp = QF + orow * 768 + hd * 96;
#pragma unroll
        for (int st = 0; st < KS; ++st) qf[st] = *(const bf16x8*)(qp + st * 16 + 8 * h);
#pragma unroll
        for (int j = 0; j < 8; ++j) {
            float crev; rope_consts(8 * h + j, crev);
            float sn, cs; rope_sc(qpos, crev, sn, cs);
            const float x1 = bf2f((unsigned short)qf[4][j]), x2 = bf2f((unsigned short)qf[5][j]);
            qf[4][j] = (short)f2bf(x1 * cs - x2 * sn); qf[5][j] = (short)f2bf(x1 * sn + x2 * cs);
        }
    } else {
        wactive = true;
        for (int id = tid; id < 128 * 36; id += 512) {
            const int rr = id / 36, ch = id % 36, hh = rr >> 4, t = rr & 15;
            u32x4 w = ch < 32 ? *(const u32x4*)(QLAT + (size_t)(b * 16 + t) * 2048 + hh * 256 + ch * 8)
                              : *(const u32x4*)(QF + (size_t)(NP + b * 16 + t) * 768 + hh * 96 + 64 + (ch - 32) * 8);
            *(u32x4*)(Qs + rr * 592 + ch * 16) = w;
        }
        __syncthreads();
        for (int id = tid; id < 128 * 16; id += 512) {
            const int rr = id >> 4, i = id & 15, t = rr & 15;
            bf16_t* qrow = (bf16_t*)(Qs + rr * 592);
            float crev; rope_consts(i, crev);
            float sn, cs; rope_sc(4096 + t, crev, sn, cs);
            const float x1 = bf2f(qrow[256 + i]), x2 = bf2f(qrow[272 + i]);
            qrow[256 + i] = f2bf(x1 * cs - x2 * sn); qrow[272 + i] = f2bf(x1 * sn + x2 * cs);
        }
    }
    const int wave_qmax = q0 + wv * 32 + 31;
    const int wave_chunk = (q0 + wv * 32) >> 6;

    f32x16 O[DB];
#pragma unroll
    for (int d = 0; d < DB; ++d) O[d] = (f32x16){};
    float carry = (MODE == 0) ? 1.f : 0.f, mrun = -INFINITY, lrun = 0.f;

    constexpr int NH = (MODE == 2) ? 1 : 2;
    u32x4 stg[NH][NST];
    auto issue = [&](int kT) {
#pragma unroll
        for (int hf = 0; hf < NH; ++hf) {
            const int kt = kT * NH + hf;
#pragma unroll
            for (int i = 0; i < NST; ++i) {
                u32x4 w = {0u, 0u, 0u, 0u};
                if constexpr (MODE == 0) {
                    const int row = tid >> 3, ch = tid & 7, kk = kt * 64 + row;
                    const int off = (i == 0 ? 512 : 1024) + hd * 64 + ch * 8;
                    if (!samp) w = *(const u32x4*)(QKVG + (size_t)(b * 2048 + kk) * 3072 + off);
                    else if (kk < 4096) w = ld_f32x8_bf16(p.in[i == 0 ? 2 : 3] + (((size_t)b * 4096 + kk) * 8 + hd) * 64 + ch * 8);
                    else if (kk < 4112) w = *(const u32x4*)(QKVG + (size_t)(NP + b * 16 + kk - 4096) * 3072 + off);
                } else if constexpr (MODE == 1) {
                    if (i == 0) { const int row = tid >> 3, ch = tid & 7; w = *(const u32x4*)(KVUP + (size_t)(b * 2048 + kt * 64 + row) * 1024 + 512 + hd * 64 + ch * 8); }
                    else {
                        const int id = tid + (i - 1) * 512;
                        if (id < 768) { const int row = id / 12, ch = id % 12; const size_t gr = (size_t)(b * 2048 + kt * 64 + row);
                            w = ch < 8 ? *(const u32x4*)(KVUP + gr * 1024 + hd * 64 + ch * 8) : *(const u32x4*)(IN1 + gr * 1792 + 1664 + (ch - 8) * 8); }
                    }
                } else {
                    const int id = tid + i * 512;
                    if (id < 2304) { const int row = id / 36, ch = id % 36, kk = kt * 64 + row;
                        if (kk < 4112) w = *(const u32x4*)(KC + ((size_t)b * 4112 + kk) * 288 + ch * 8); }
                }
                stg[hf][i] = w;
            }
        }
    };
    auto commit = [&]() {
#pragma unroll
        for (int hf = 0; hf < NH; ++hf) {
            unsigned char* Kh = Ks + hf * 64 * C::KSTR; unsigned char* Vh = Vs + hf * 64 * C::VSTR;
#pragma unroll
            for (int i = 0; i < NST; ++i) {
                if constexpr (MODE == 0) { const int row = tid >> 3, ch = tid & 7; *(u32x4*)((i == 0 ? Kh + row * C::KSTR : Vh + row * C::VSTR) + ch * 16) = stg[hf][i]; }
                else if constexpr (MODE == 1) {
                    if (i == 0) { const int row = tid >> 3, ch = tid & 7; *(u32x4*)(Vh + row * C::VSTR + ch * 16) = stg[hf][0]; }
                    else { const int id = tid + (i - 1) * 512; if (id < 768) { const int row = id / 12, ch = id % 12; *(u32x4*)(Kh + row * C::KSTR + ch * 16) = stg[hf][i]; } }
                } else { const int id = tid + i * 512; if (id < 2304) { const int row = id / 36, ch = id % 36; *(u32x4*)(Kh + row * C::KSTR + ch * 16) = stg[hf][i]; } }
            }
        }
    };

    const int kT_last = kt_last / NH;
    issue(kT_last);
    int done = wactive ? 0 : 1, par = 0;
    for (int kT = kT_last; kT >= 0; --kT) {
        if constexpr (MODE == 0) { if (lane == 0) flags[par * 8 + wv] = done; }
        __syncthreads();
        if constexpr (MODE == 0) {
            int all = 1;
#pragma unroll
            for (int w = 0; w < 8; ++w) all &= flags[par * 8 + w];
            par ^= 1;
            if (all) break;
        }
        commit();
        __syncthreads();
        if (kT > 0) issue(kT - 1);
      f32x16 SA[NH][2]; bool relq[NH];
#pragma unroll
      for (int hfi = 0; hfi < NH; ++hfi) {
        const int hf = NH - 1 - hfi, kt = kT * NH + hf;
        unsigned char* Ks = smem + hf * 64 * C::KSTR;
        bool rel = wactive && (kt <= kt_last);
        if constexpr (MODE == 0) rel = rel && !done && (samp || kt * 64 < wave_qmax);
        if constexpr (MODE == 1) rel = rel && (kt <= wave_chunk);
        relq[hf] = rel;
        SA[hf][0] = (f32x16){}; SA[hf][1] = (f32x16){};
        if (rel) {
                constexpr int CH = (KS % 6 == 0) ? 6 : 4;
#pragma unroll
                for (int c0 = 0; c0 < KS; c0 += CH) {
                    bf16x8 ka[2][CH], qb[CH];
#pragma unroll
                    for (int s = 0; s < CH; ++s) {
                        ka[0][s] = *(const bf16x8*)(Ks + (r) * C::KSTR + ((c0 + s) * 16 + 8 * h) * 2);
                        ka[1][s] = *(const bf16x8*)(Ks + (32 + r) * C::KSTR + ((c0 + s) * 16 + 8 * h) * 2);
                        if constexpr (MODE == 2) qb[s] = *(const bf16x8*)(Qs + (rg * 32 + r) * 592 + ((c0 + s) * 16 + 8 * h) * 2); else qb[s] = qf[c0 + s];
                    }
                    __builtin_amdgcn_sched_barrier(0);
#pragma unroll
                    for (int s = 0; s < CH; ++s) {
                        SA[hf][0] = __builtin_amdgcn_mfma_f32_32x32x16_bf16(ka[0][s], qb[s], SA[hf][0], 0, 0, 0);
                        SA[hf][1] = __builtin_amdgcn_mfma_f32_32x32x16_bf16(ka[1][s], qb[s], SA[hf][1], 0, 0, 0);
                    }
                }
        }
      }
#pragma unroll
      for (int hfi = 0; hfi < NH; ++hfi) {
        const int hf = NH - 1 - hfi, kt = kT * NH + hf;
        unsigned char* Vs = ((MODE == 2) ? smem : smem + SM_V) + hf * 64 * C::VSTR;
        bool rel = relq[hf];
        if constexpr (MODE == 0) rel = rel && !done;
        if (rel) {
            f32x16 (&S)[2] = SA[hf];
            bf16x8 pf[2][2];
            if constexpr (MODE == 0) {
#pragma unroll
                for (int kbi = 0; kbi < 2; ++kbi) {
                    const int kb = 1 - kbi;
                    float bt[16], qv[16];
#pragma unroll
                    for (int reg = 0; reg < 16; ++reg) {
                        const int kk = kt * 64 + kb * 32 + (reg & 3) + 8 * (reg >> 2) + 4 * h;
                        const bool v = qvalid && (kk < qpos);
                        const float t = __builtin_amdgcn_exp2f(fminf(S[kb][reg], 120.f));
                        const float q = __builtin_amdgcn_rcpf(1.f + t);
                        bt[reg] = v ? t * q : 0.f; qv[reg] = v ? q : 1.f;
                    }
                    float G[4], PG[4], T[4];
#pragma unroll
                    for (int g = 0; g < 4; ++g) { G[g] = (qv[4 * g] * qv[4 * g + 1]) * (qv[4 * g + 2] * qv[4 * g + 3]); PG[g] = __shfl_xor(G[g], 32); }
                    T[3] = 1.f; T[2] = G[3] * PG[3]; T[1] = T[2] * (G[2] * PG[2]); T[0] = T[1] * (G[1] * PG[1]);
                    const float total = T[0] * (G[0] * PG[0]);
                    float w[16];
#pragma unroll
                    for (int g = 0; g < 4; ++g) {
                        float run = carry * T[g] * (h == 0 ? PG[g] : 1.f);
#pragma unroll
                        for (int i = 3; i >= 0; --i) {
                            const int reg = 4 * g + i;
                            w[reg] = bt[reg] * run;
                            run *= qv[reg];
                        }
                    }
                    carry *= total;
#pragma unroll
                    for (int s = 0; s < 2; ++s) {
                        u32x4 u; u.x = pk2(w[8 * s], w[8 * s + 1]); u.y = pk2(w[8 * s + 2], w[8 * s + 3]); u.z = pk2(w[8 * s + 4], w[8 * s + 5]); u.w = pk2(w[8 * s + 6], w[8 * s + 7]);
                        pf[kb][s] = __builtin_bit_cast(bf16x8, u);
                    }
                }
                done = __all((!qvalid) || (carry < 1e-36f)) ? 1 : 0;
            } else {
                float mx = -INFINITY;
#pragma unroll
                for (int kb = 0; kb < 2; ++kb)
#pragma unroll
                    for (int reg = 0; reg < 16; ++reg) {
                        if constexpr (MODE == 2) { const int kk = kt * 64 + kb * 32 + (reg & 3) + 8 * (reg >> 2) + 4 * h; if (kk >= 4112) S[kb][reg] = -INFINITY; }
                        mx = fmaxf(mx, S[kb][reg]);
                    }
                mx = fmaxf(mx, __shfl_xor(mx, 32));
                const float mn = fmaxf(mrun, mx);
                const float alpha = __builtin_amdgcn_exp2f(mrun - mn);
                mrun = mn;
                float ls = 0.f;
#pragma unroll
                for (int kb = 0; kb < 2; ++kb) {
                    float w[16];
#pragma unroll
                    for (int reg = 0; reg < 16; ++reg) { w[reg] = __builtin_amdgcn_exp2f(S[kb][reg] - mn); ls += w[reg]; }
#pragma unroll
                    for (int s = 0; s < 2; ++s) {
                        u32x4 u; u.x = pk2(w[8 * s], w[8 * s + 1]); u.y = pk2(w[8 * s + 2], w[8 * s + 3]); u.z = pk2(w[8 * s + 4], w[8 * s + 5]); u.w = pk2(w[8 * s + 6], w[8 * s + 7]);
                        pf[kb][s] = __builtin_bit_cast(bf16x8, u);
                    }
                }
                lrun = lrun * alpha + ls;
                if (!__all(alpha == 1.f)) {
#pragma unroll
                    for (int d = 0; d < DB; ++d) O[d] = O[d] * alpha;
                }
            }
#pragma unroll
            for (int d = 0; d < DB; ++d) {
                bf16x8 va[2][2];
#pragma unroll
                for (int kb = 0; kb < 2; ++kb)
#pragma unroll
                    for (int s = 0; s < 2; ++s) {
                        const unsigned char* vp = Vs + (kb * 32 + 16 * s + 4 * h + q4) * C::VSTR + ((dvh * 4 + d) * 32 + 16 * (grp & 1) + 4 * pp) * 2;
                        s4v lo = tr_read(vp), hi = tr_read(vp + 8 * C::VSTR);
                        va[kb][s] = __builtin_shufflevector(lo, hi, 0, 1, 2, 3, 4, 5, 6, 7);
                    }
                __builtin_amdgcn_sched_barrier(0);
#pragma unroll
                for (int kb = 0; kb < 2; ++kb)
#pragma unroll
                    for (int s = 0; s < 2; ++s) O[d] = __builtin_amdgcn_mfma_f32_32x32x16_bf16(va[kb][s], pf[kb][s], O[d], 0, 0, 0);
            }
        }
      }
    }
    if (MODE == 0 || MODE == 1) {
        float inv = 1.f;
        if constexpr (MODE == 1) { const float l = lrun + __shfl_xor(lrun, 32); inv = 1.f / l; }
        if (wactive && qvalid) {
            bf16_t* op = (MODE == 0) ? (bf16_t*)(p.ws + WS_R1 + R1_MIXED) + orow * 1024 + hd * 64
                                     : (bf16_t*)(p.ws + WS_R1 + R1_MIXED2) + orow * 1024 + 512 + hd * 64;
#pragma unroll
            for (int d = 0; d < DB; ++d)
#pragma unroll
                for (int g = 0; g < 4; ++g) {
                    u32x2 w; w.x = pk2(O[d][4 * g] * inv, O[d][4 * g + 1] * inv); w.y = pk2(O[d][4 * g + 2] * inv, O[d][4 * g + 3] * inv);
                    *(u32x2*)(op + d * 32 + 8 * g + 4 * h) = w;
                }
        }
    } else {
        const float l = lrun + __shfl_xor(lrun, 32);
        const float inv = 1.f / l;
        __syncthreads();
        float* OL = (float*)smem;
        if (wactive) {
            const int rr = rg * 32 + r;
#pragma unroll
            for (int d = 0; d < DB; ++d)
#pragma unroll
                for (int g = 0; g < 4; ++g)
                    *(f32x4*)(OL + rr * 256 + (dvh * 4 + d) * 32 + 8 * g + 4 * h) = (f32x4){O[d][4 * g] * inv, O[d][4 * g + 1] * inv, O[d][4 * g + 2] * inv, O[d][4 * g + 3] * inv};
        }
        __syncthreads();
        const int hh = tid >> 6, v = tid & 63;
        const float* wuv = p.in[23] + (size_t)hh * 256 * 64 + v;
        float acc[16];
#pragma unroll
        for (int t = 0; t < 16; ++t) acc[t] = 0.f;
        for (int c = 0; c < 256; ++c) {
            const float w = wuv[(size_t)c * 64];
#pragma unroll
            for (int t = 0; t < 16; ++t) acc[t] += OL[(hh * 16 + t) * 256 + c] * w;
        }
        bf16_t* MX = (bf16_t*)(p.ws + WS_R1 + R1_MIXED2);
#pragma unroll
        for (int t = 0; t < 16; ++t) MX[(size_t)(NP + b * 16 + t) * 1024 + 512 + hh * 64 + v] = f2bf(acc[t]);
    }
}

#define XB_TMO      128
#define XB_XCNT(j)  (256  + 64 * (j))
#define XB_XSUB(j)  (1280 + 64 * (j))
#define XB_XGEN(j)  (2304 + 64 * (j))
#define XB_TOP      3328
#define XB_TOPGEN   3392
#define XCD_BAR_WORDS 3456
#define XB_SPIN_CAP (1u << 21)
DEVI unsigned xb_ld(unsigned* p)              { return __hip_atomic_load(p, __ATOMIC_RELAXED, __HIP_MEMORY_SCOPE_AGENT); }
DEVI unsigned xb_add(unsigned* p, unsigned v) { return __hip_atomic_fetch_add(p, v, __ATOMIC_RELAXED, __HIP_MEMORY_SCOPE_AGENT); }
DEVI unsigned xb_xcc_id() { return (unsigned)__builtin_amdgcn_s_getreg((3 << 11) | 20) & 0xFu; }
#define XB_SPIN(cond, bar) do { unsigned _sp = 0; while (cond) { __builtin_amdgcn_s_sleep(1); \
    if ((++_sp & 255u) == 0u) { if (xb_ld(&(bar)[XB_TMO])) break; if (_sp > XB_SPIN_CAP) { atomicAdd(&(bar)[XB_TMO], 1u); break; } } } } while (0)
struct XcdBarrier { unsigned* bar; unsigned x; volatile LAS unsigned* st; };
DEVI XcdBarrier xcd_barrier_post(unsigned* bar, volatile LAS unsigned* st) {
    XcdBarrier b; b.bar = bar; b.x = xb_xcc_id(); b.st = st;
    if (threadIdx.x == 0) (void)xb_add(&bar[XB_XCNT(b.x)], 1u);
    return b;
}
DEVI void xcd_barrier_complete(unsigned* bar, unsigned x, unsigned& nloc, unsigned& nx) {
    const unsigned G = gridDim.x * gridDim.y * gridDim.z;
    unsigned sum, cnt, mine, sp = 0u;
    for (;;) {
        sum = 0u; cnt = 0u; mine = 0u;
#pragma unroll
        for (unsigned j = 0; j < 16; ++j) { const unsigned c = xb_ld(&bar[XB_XCNT(j)]); sum += c; cnt += (c > 0u) ? 1u : 0u; mine = (j == x) ? c : mine; }
        if (sum == G) break;
        __builtin_amdgcn_s_sleep(1);
        if ((++sp & 255u) == 0u) { if (xb_ld(&bar[XB_TMO])) break; if (sp > XB_SPIN_CAP) { atomicAdd(&bar[XB_TMO], 1u); break; } }
    }
    nloc = mine > 0u ? mine : 1u; nx = cnt > 0u ? cnt : 1u;
}
DEVI void xcd_barrier(const XcdBarrier& b) {
    asm volatile("s_waitcnt vmcnt(0)" ::: "memory");
    __syncthreads();
    if (threadIdx.x == 0) {
        unsigned* bar = b.bar;
        __builtin_amdgcn_s_waitcnt(0);
        unsigned nloc = b.st[0], nx = b.st[1];
        if (nloc == 0u) { xcd_barrier_complete(bar, b.x, nloc, nx); b.st[0] = nloc; b.st[1] = nx; }
        const unsigned old = xb_add(&bar[XB_XSUB(b.x)], 1u);
        const unsigned gen = old / nloc;
        if (old + 1u == (gen + 1u) * nloc) {
            __builtin_amdgcn_fence(__ATOMIC_RELEASE, "agent");
            asm volatile("s_waitcnt vmcnt(0)" ::: "memory");
            const unsigned og = xb_add(&bar[XB_TOP], 1u);
            const unsigned tg = og / nx;
            if (og + 1u == (tg + 1u) * nx) xb_add(&bar[XB_TOPGEN], 1u);
            else XB_SPIN(xb_ld(&bar[XB_TOPGEN]) == tg, bar);
            __builtin_amdgcn_fence(__ATOMIC_ACQUIRE, "agent");
            xb_add(&bar[XB_XGEN(b.x)], 1u);
            asm volatile("s_waitcnt vmcnt(0)" ::: "memory");
        } else {
            XB_SPIN(xb_ld(&bar[XB_XGEN(b.x)]) == gen, bar);
            __builtin_amdgcn_fence(__ATOMIC_ACQUIRE, "agent");
            asm volatile("s_waitcnt vmcnt(0)" ::: "memory");
        }
    }
    __syncthreads();
}

DEVI int next_item(unsigned* ctr, int* slot) {
    __syncthreads();
    if (threadIdx.x == 0) *slot = (int)atomicAdd(ctr, 1u);
    __syncthreads();
    return *slot;
}

__global__ void __launch_bounds__(512) mega(Params p, int ph_lo, int ph_hi, int coop) {
    __shared__ __attribute__((aligned(16))) unsigned char smem[131072];
    __shared__ int s_item;
    __shared__ uint4 xb_words;
    if (threadIdx.x == 0) xb_words = make_uint4(0u, 0u, 0u, 0u);
    __syncthreads();
    XcdBarrier xb = xcd_barrier_post((unsigned*)(p.ws + WS_CTR), (volatile LAS unsigned*)&xb_words);
    unsigned* ctr = (unsigned*)(p.ws + WS_CTR);
    bf16_t* shm = (bf16_t*)smem;
    unsigned char* ws = p.ws;
    bf16_t* H = (bf16_t*)(ws + WS_H);
    bf16_t* Ob = (bf16_t*)(ws + WS_O);
    bf16_t* R1 = (bf16_t*)(ws + WS_R1);

    for (int ph = ph_lo; ph < ph_hi; ++ph) {
        if (ph > ph_lo && coop) { if (ph == 1) cg::this_grid().sync(); else xcd_barrier(xb); }
        const int layer = ph >= 8 ? 1 : 0;
        constexpr int rep = 0;
        switch (ph) {
        case 0: phase_prep(p, (float*)smem); break;
        case 1: {
            bf16_t* Q = R1;
            const bf16_t* W = (const bf16_t*)(ws + WS_W1T);
            auto emit = [&](int row, int col, f32x4 v0, f32x4 v1) { bf16_t* d = Q + (size_t)row * 3072 + col; st_bf16x8(d, v0, v1); };
            gemm_run<16>(H, 1024, W, 1024, 1024, shm, [&](int i, int& br, int& bc) { const int it = blockIdx.x + i * gridDim.x; if (it >= 256 * 12) return false; int pm, pn; tile_map(it, 256, 12, pm, pn); br = pm * 256; bc = pn * 256; return true; }, emit);
            for (int it = blockIdx.x; it < 8 * 48; it += gridDim.x) gemm_small<8>(H, 1024, W, 1024, 1024, NP + (it & 7) * 64, (it >> 3) * 64, (float*)smem, emit);
        } break;
        case 2: {
            for (;;) {
                const int it = next_item(ctr + 0 + 2 * rep, &s_item);
                if (it >= 2304 + 2064 + 1152) break;
                if (it >= 2304 + 2064) { kc_item(p, it - (2304 + 2064)); continue; }
                if (it < 2 * 2064) { if (it & 1) conv_item(p, it >> 1); else attn_item<0>(p, it >> 1, smem); }
                else attn_item<0>(p, it - 2064, smem);
            }
        } break;
        case 3: case 12: {
            const bf16_t* A = R1 + (layer ? R1_MIXED2 : R1_MIXED) / 2;
            const bf16_t* W = (const bf16_t*)(ws + (layer ? WS_WO2T : WS_WO1T));
            auto emit = [&](int row, int col, f32x4 v0, f32x4 v1) { bf16_t* d = Ob + (size_t)row * 1024 + col; st_bf16x8(d, v0, v1); };
            gemm_run<16>(A, 1024, W, 1024, 1024, shm, [&](int i, int& br, int& bc) { const int it = blockIdx.x + i * gridDim.x; if (it >= 256 * 4) return false; int pm, pn; tile_map(it, 256, 4, pm, pn); br = pm * 256; bc = pn * 256; return true; }, emit);
            for (int it = blockIdx.x; it < 8 * 16; it += gridDim.x) gemm_small<8>(A, 1024, W, 1024, 1024, NP + (it & 7) * 64, (it >> 3) * 64, (float*)smem, emit);
        } break;
        case 4: phase_rowpass(p, true, p.in[8], false); break;
        case 13: phase_rowpass(p, false, p.in[8] + 1024, false); break;
        case 5: case 14: {
            bf16_t* ACT = R1;
            const bf16_t* W = (const bf16_t*)(ws + (layer ? WS_WUP1 : WS_WUP0));
            auto emit = [&](int row, int col, f32x4 v0, f32x4 v1) {
#pragma unroll
                for (int k = 0; k < 4; ++k) { float a = fmaxf(v0[k], 0.f), b2 = fmaxf(v1[k], 0.f); v0[k] = a * a; v1[k] = b2 * b2; }
                bf16_t* d = ACT + (size_t)row * 4096 + col; st_bf16x8(d, v0, v1);
            };
            gemm_run<16>(H, 1024, W, 1024, 1024, shm, [&](int i, int& br, int& bc) { const int it = blockIdx.x + i * gridDim.x; if (it >= 256 * 16) return false; int pm, pn; tile_map(it, 256, 16, pm, pn); br = pm * 256; bc = pn * 256; return true; }, emit);
            for (int it = blockIdx.x; it < 8 * 64; it += gridDim.x) gemm_small<8>(H, 1024, W, 1024, 1024, NP + (it & 7) * 64, (it >> 3) * 64, (float*)smem, emit);
        } break;
        case 6: case 15: {
            const bf16_t* ACT = R1;
            const bf16_t* W = (const bf16_t*)(ws + (layer ? WS_WDN1 : WS_WDN0));
            auto emit = [&](int row, int col, f32x4 v0, f32x4 v1) { bf16_t* d = Ob + (size_t)row * 1024 + col; st_bf16x8(d, v0, v1); };
            gemm_run<16>(ACT, 4096, W, 4096, 4096, shm, [&](int i, int& br, int& bc) { if (i >= 4) return false; const int it = blockIdx.x + (3 - i) * gridDim.x;     int pm, pn; tile_map(it, 256, 4, pm, pn); br = pm * 256; bc = pn * 256; return true; }, emit);
            for (int it = blockIdx.x; it < 8 * 16; it += gridDim.x) gemm_small<8>(ACT, 4096, W, 4096, 4096, NP + (it & 7) * 64, (it >> 3) * 64, (float*)smem, emit);
        } break;
        case 7: phase_rowpass(p, false, p.in[10], false); break;
        case 16: phase_rowpass(p, false, p.in[10] + 1024, true); break;
        case 8: {
            bf16_t* IN1 = R1;
            const bf16_t* W = (const bf16_t*)(ws + WS_W2T);
            auto emit = [&](int row, int col, f32x4 v0, f32x4 v1) { bf16_t* d = IN1 + (size_t)row * 1792 + col; st_bf16x8(d, v0, v1); };
            gemm_run<16>(H, 1024, W, 1024, 1024, shm, [&](int i, int& br, int& bc) { const int it = blockIdx.x + i * gridDim.x; if (it >= 256 * 7) return false; int pm, pn; tile_map(it, 256, 7, pm, pn); br = pm * 256; bc = pn * 256; return true; }, emit);
            for (int it = blockIdx.x; it < 8 * 28; it += gridDim.x) gemm_small<8>(H, 1024, W, 1024, 1024, NP + (it & 7) * 64, (it >> 3) * 64, (float*)smem, emit);
        } break;
        case 9: phase_l1rows(p); break;
        case 10: {
            const bf16_t* IN1 = R1;
            bf16_t* QF = R1 + R1_QF / 2; bf16_t* KVUP = R1 + R1_KVUP / 2; bf16_t* QLAT = R1 + R1_QLAT / 2;
            auto emit_kv = [&](int row, int col, f32x4 v0, f32x4 v1) { bf16_t* d = KVUP + (size_t)row * 1024 + col; st_bf16x8(d, v0, v1); };
            auto emit_qf = [&](int row, int col, f32x4 v0, f32x4 v1) { bf16_t* d = QF + (size_t)row * 768 + col; st_bf16x8(d, v0, v1); };
            auto emit_ql = [&](int row, int col, f32x4 v0, f32x4 v1) { bf16_t* d = QLAT + (size_t)(row - NP) * 2048 + col; st_bf16x8(d, v0, v1); };
            gemm_run<0>(IN1 + 1408, 1792, (const bf16_t*)(ws + WS_WKVT), 256, 256, shm, [&](int i, int& br, int& bc) { const int it = blockIdx.x + i * gridDim.x; if (it >= 256 * 4) return false; int pm, pn; tile_map(it, 256, 4, pm, pn); br = pm * 256; bc = pn * 256; return true; }, emit_kv);
            gemm_run<0>(IN1 + 1024, 1792, (const bf16_t*)(ws + WS_WUQT), 384, 384, shm, [&](int i, int& br, int& bc) { const int it = blockIdx.x + i * gridDim.x; if (it >= 256 * 3) return false; int pm, pn; tile_map(it, 256, 3, pm, pn); br = pm * 256; bc = pn * 256; return true; }, emit_qf);
            for (int it = blockIdx.x; it < 8 * 12 + 8 * 32; it += gridDim.x) {
                if (it < 96) gemm_small<4>(IN1 + 1024, 1792, (const bf16_t*)(ws + WS_WUQT), 384, 384, NP + (it & 7) * 64, (it >> 3) * 64, (float*)smem, emit_qf);
                else { const int i2 = it - 96; gemm_small<4>(IN1 + 1024, 1792, (const bf16_t*)(ws + WS_WQLT), 384, 384, NP + (i2 & 7) * 64, (i2 >> 3) * 64, (float*)smem, emit_ql); }
            }
        } break;
        case 11: {
            for (;;) {
                int it = next_item(ctr + 1 + 2 * rep, &s_item);
                if (it >= 32 + 2048 + 2176) break;
                if (it < 32) attn_item<2>(p, it, smem);
                else {
                    const int i2 = it - 32;
                    if (i2 < 2 * 2048) { if (i2 & 1) sgu_item(p, i2 >> 1, smem); else attn_item<1>(p, i2 >> 1, smem); }
                    else sgu_item(p, i2 - 2048, smem);
                }
            }
        } break;
        default: break;
        }
    }
}

constexpr int NPHASE = 17;

extern "C" void kernel_launch(void* const* d_in, const int* in_sizes, int n_in, void* d_out, int out_size, void* d_ws, size_t ws_size, hipStream_t stream) {
    static int grid = 0;
    if (grid == 0) {
        int dev = 0, cus = 0, per_cu = 0;
        hipGetDevice(&dev);
        hipDeviceGetAttribute(&cus, hipDeviceAttributeMultiprocessorCount, dev);
        hipOccupancyMaxActiveBlocksPerMultiprocessor(&per_cu, mega, 512, 0);
        if (per_cu < 1) per_cu = 1;
        grid = cus * 1;
        if (ws_size < WS_END) { fprintf(stderr, "kernel_launch: workspace too small: %zu < %zu\n", ws_size, (size_t)WS_END); grid = -1; }
    }
    if (grid < 0) return;
    Params p{};
    for (int i = 0; i < 27; ++i) p.in[i] = (const float*)d_in[i];
    p.out = (float*)d_out; p.ws = (unsigned char*)d_ws;
    hipMemsetAsync(d_ws, 0, 16384, stream);
#ifdef MULTI_LAUNCH
    for (int ph = 0; ph < NPHASE; ++ph) hipLaunchKernelGGL(mega, dim3(grid), dim3(512), 0, stream, p, ph, ph + 1, 0);
#else
    int lo = 0, hi = NPHASE, coop = 1;
    void* args[] = {&p, &lo, &hi, &coop};
    hipError_t e = hipLaunchCooperativeKernel((void*)mega, dim3(grid), dim3(512), args, 0, stream);
    if (e != hipSuccess) fprintf(stderr, "cooperative launch failed: %s (grid %d)\n", hipGetErrorString(e), grid);
#endif
}
```

```cpp
#include <hip/hip_runtime.h>
#include <hip/hip_cooperative_groups.h>
#include <cstdio>
#include <cstdint>
namespace cg = cooperative_groups;

#define DEVI __device__ __forceinline__
typedef unsigned short bf16_t;
typedef short bf16x8 __attribute__((ext_vector_type(8)));
typedef short s4v __attribute__((ext_vector_type(4)));
typedef float f32x4 __attribute__((ext_vector_type(4)));
typedef float f32x16 __attribute__((ext_vector_type(16)));
typedef unsigned u32x4 __attribute__((ext_vector_type(4)));
typedef unsigned u32x2 __attribute__((ext_vector_type(2)));

constexpr int NP = 65536;
constexpr int NS = 512;
constexpr int MT = NP + NS;
constexpr float EPS = 1e-6f;
constexpr float LOG2E = 1.4426950408889634f;
constexpr float SBQ = 0.125f * LOG2E;
constexpr float MLQ = 0.10206207261596577f * LOG2E;

constexpr size_t O_Y = 0;
constexpr size_t O_SBK_P = (size_t)MT * 1024;
constexpr size_t O_SBV_P = O_SBK_P + (size_t)NP * 512;
constexpr size_t O_CONV_P = O_SBV_P + (size_t)NP * 512;
constexpr size_t O_CKV_P = O_CONV_P + 32 * 2 * 512;
constexpr size_t O_KPE_P = O_CKV_P + (size_t)NP * 256;
constexpr size_t O_SBK_S = O_KPE_P + (size_t)NP * 32;
constexpr size_t O_SBV_S = O_SBK_S + (size_t)NS * 512;
constexpr size_t O_CONV_S = O_SBV_S + (size_t)NS * 512;
constexpr size_t O_CKV_S = O_CONV_S + 32 * 2 * 512;
constexpr size_t O_KPE_S = O_CKV_S + (size_t)NS * 256;
constexpr size_t O_SGUV_S = O_KPE_S + (size_t)NS * 32;

constexpr size_t WS_CTR = 0;
constexpr size_t WS_W1T = 16384;
constexpr size_t WS_WO1T = WS_W1T + 3072ull * 1024 * 2;
constexpr size_t WS_WUP0 = WS_WO1T + 1024ull * 1024 * 2;
constexpr size_t WS_WDN0 = WS_WUP0 + 4096ull * 1024 * 2;
constexpr size_t WS_WUP1 = WS_WDN0 + 4096ull * 1024 * 2;
constexpr size_t WS_WDN1 = WS_WUP1 + 4096ull * 1024 * 2;
constexpr size_t WS_W2T = WS_WDN1 + 4096ull * 1024 * 2;
constexpr size_t WS_WUQT = WS_W2T + 1792ull * 1024 * 2;
constexpr size_t WS_WKVT = WS_WUQT + 768ull * 384 * 2;
constexpr size_t WS_WQLT = WS_WKVT + 1024ull * 256 * 2;
constexpr size_t WS_WO2T = WS_WQLT + 2048ull * 384 * 2;
constexpr size_t WS_H = WS_WO2T + 1024ull * 1024 * 2;
constexpr size_t WS_O = WS_H + (size_t)MT * 1024 * 2;
constexpr size_t WS_KC = WS_O + (size_t)MT * 1024 * 2;
constexpr size_t WS_R1 = WS_KC + 32ull * 4112 * 288 * 2;
constexpr size_t R1_QKVG = 0;
constexpr size_t R1_MIXED = (size_t)MT * 3072 * 2;
constexpr size_t R1_ACT = 0;
constexpr size_t R1_IN1 = 0;
constexpr size_t R1_QF = (size_t)MT * 1792 * 2;
constexpr size_t R1_KVUP = R1_QF + (size_t)MT * 768 * 2;
constexpr size_t R1_QLAT = R1_KVUP + (size_t)MT * 1024 * 2;
constexpr size_t R1_MIXED2 = R1_QLAT + 512ull * 2048 * 2;
constexpr size_t WS_RS = WS_R1 + R1_MIXED2 + (size_t)MT * 1024 * 2;
constexpr size_t WS_END = WS_RS + (size_t)MT * 4;

struct Params {
    const float* in[27];
    float* out;
    unsigned char* ws;
};

typedef __bf16 bf2v __attribute__((ext_vector_type(2)));
DEVI unsigned short f2bf(float f) { __bf16 v = (__bf16)f; return __builtin_bit_cast(unsigned short, v); }
DEVI unsigned pk2(float a, float b) { bf2v v = {(__bf16)a, (__bf16)b}; return __builtin_bit_cast(unsigned, v); }
DEVI float bflo(unsigned w) { return __uint_as_float(w << 16); }
DEVI float bfhi(unsigned w) { return __uint_as_float(w & 0xffff0000u); }
DEVI float bf2f(unsigned short h) { return __uint_as_float(((unsigned)h) << 16); }
DEVI float wave_sum(float v) {
#pragma unroll
    for (int o = 32; o > 0; o >>= 1) v += __shfl_xor(v, o);
    return v;
}
DEVI void unpack8(u32x4 w, float* f) {
    f[0] = bflo(w.x); f[1] = bfhi(w.x); f[2] = bflo(w.y); f[3] = bfhi(w.y);
    f[4] = bflo(w.z); f[5] = bfhi(w.z); f[6] = bflo(w.w); f[7] = bfhi(w.w);
}
DEVI u32x4 pack8(const float* f) { u32x4 w; w.x = pk2(f[0], f[1]); w.y = pk2(f[2], f[3]); w.z = pk2(f[4], f[5]); w.w = pk2(f[6], f[7]); return w; }
DEVI int get_tid() { int t = threadIdx.x; asm volatile("" : "+v"(t)); return t; }
DEVI int row_pos(int row) { return row < NP ? (row & 2047) : 4096 + ((row - NP) & 15); }

constexpr int BM = 256, BK = 64, HALF = 128, HT = HALF * BK;
DEVI int lds_byte(int r, int c) {
    int st = (r >> 4) * 2 + (c >> 5), rr = r & 15, cc = c & 31, ob = rr * 64 + cc * 2;
    return st * 1024 + (ob ^ (((ob >> 9) & 1) << 5));
}
DEVI void stage_rc(int b, int& R, int& C) {
    int st = b / 1024, sb = b % 1024, swz = sb ^ (((sb >> 9) & 1) << 5);
    R = (st >> 1) * 16 + swz / 64; C = (st & 1) * 32 + (swz % 64) / 2;
}

#define LAS __attribute__((address_space(3)))
template <int NSTORE, class TF, class F>
DEVI void gemm_run(const bf16_t* __restrict__ A, int lda, const bf16_t* __restrict__ Bt, int ldb, int K, bf16_t* shm, TF&& tile, F&& emit) {
    LAS unsigned char* lds = (LAS unsigned char*)shm;
    const int tid = get_tid(), wid = __builtin_amdgcn_readfirstlane(tid >> 6), lane = tid & 63, wr = wid >> 2, wc = wid & 3, fr = lane & 15, fq = lane >> 4;
    const int nt = K / BK;
    unsigned voffA[2], voffB[2];
#pragma unroll
    for (int i = 0; i < 2; ++i) { int R, C; stage_rc(tid * 16 + i * 8192, R, C); const int rho = R & 31; const int Rb = (R & ~31) + (8 * ((rho & 15) >> 2) + 4 * (rho >> 4) + (rho & 3));
        voffA[i] = (unsigned)(R * lda + C) * 2u; voffB[i] = (unsigned)(Rb * ldb + C) * 2u; }
    const size_t kstep = (size_t)(BK * 2);
    const size_t hstepA = (size_t)HALF * lda * 2, hstepB = (size_t)HALF * ldb * 2;
    const unsigned ldsw = (unsigned)wid * 1024u;
    const int aoff = lds_byte(wr * 64 + fr, fq * 8), boff = lds_byte(wc * 32 + fr, fq * 8);
    constexpr int HTB = HALF * BK * 2;
#define G_SA(b, h) (((b) * 2 + (h)) * HTB)
#define G_SB(b, h) ((4 + (b) * 2 + (h)) * HTB)
#define G_STAGE(bufoff, gbase, voff) do { _Pragma("unroll") for (int _i = 0; _i < 2; ++_i) \
        __builtin_amdgcn_global_load_lds((const unsigned*)((const char*)(gbase) + (voff)[_i]), (LAS unsigned*)(lds + (bufoff) + ldsw + _i * 8192), 16, 0, 0); } while (0)
#define G_LDA(dst, b, h) do { _Pragma("unroll") for (int m = 0; m < 4; ++m) _Pragma("unroll") for (int k = 0; k < 2; ++k) dst[m][k] = *(const LAS bf16x8*)(lds + G_SA(b, h) + aoff + m * 2048 + k * 1024); } while (0)
#define G_LDB(dst, b, h) do { _Pragma("unroll") for (int n = 0; n < 2; ++n) _Pragma("unroll") for (int k = 0; k < 2; ++k) dst[n][k] = *(const LAS bf16x8*)(lds + G_SB(b, h) + boff + n * 2048 + k * 1024); } while (0)
#define G_MMA(ai, bj, At, Bt_) do { __builtin_amdgcn_s_setprio(1); _Pragma("unroll") for (int m = 0; m < 4; ++m) _Pragma("unroll") for (int n = 0; n < 2; ++n) _Pragma("unroll") for (int k = 0; k < 2; ++k) \
        acc[ai][bj][m][n] = __builtin_amdgcn_mfma_f32_16x16x32_bf16(Bt_[n][k], At[m][k], acc[ai][bj][m][n], 0, 0, 0); __builtin_amdgcn_s_setprio(0); } while (0)
#define G_WAIT_V(n) asm volatile("s_waitcnt vmcnt(" #n ")" ::: "memory")
#define G_WAIT_L(n) asm volatile("s_waitcnt lgkmcnt(" #n ")" ::: "memory")
#define G_BAR __builtin_amdgcn_s_barrier()
#define G_SCHED __builtin_amdgcn_sched_barrier(0)
    int brow, bcol, nrow, ncol; int ui = 0;
    if (!tile(0, brow, bcol)) return;
    f32x4 acc[2][2][4][2];
#pragma unroll
    for (int a = 0; a < 2; ++a)
#pragma unroll
        for (int b = 0; b < 2; ++b)
#pragma unroll
            for (int m = 0; m < 4; ++m)
#pragma unroll
                for (int n = 0; n < 2; ++n) acc[a][b][m][n] = (f32x4){0.f, 0.f, 0.f, 0.f};
    bf16x8 At[4][2], B0[2][2], B1[2][2];
    const char* cA = (const char*)A + (size_t)brow * lda * 2; const char* cB = (const char*)Bt + (size_t)bcol * ldb * 2;
    G_STAGE(G_SB(0, 0), cB, voffB); G_STAGE(G_SB(0, 1), cB + hstepB, voffB); G_STAGE(G_SA(0, 0), cA, voffA); G_STAGE(G_SA(0, 1), cA + hstepA, voffA);
    if (wr == 1) G_BAR;
    G_WAIT_V(2); G_BAR;
    G_STAGE(G_SB(1, 0), cB + kstep, voffB); G_STAGE(G_SA(1, 0), cA + kstep, voffA); G_STAGE(G_SB(1, 1), cB + hstepB + kstep, voffB);
    G_WAIT_V(6); G_BAR;
    for (;;) {
        const bool has_next = tile(ui + 1, nrow, ncol);
        const char* nA = has_next ? (const char*)A + (size_t)nrow * lda * 2 : cA; const char* nB = has_next ? (const char*)Bt + (size_t)ncol * ldb * 2 : cB;
        for (int t = 0; t < nt; t += 2) {
            const bool last = (t == nt - 2);
            const char* a1 = cA + (size_t)(t + 1) * kstep;
            const char* a2 = last ? nA : cA + (size_t)(t + 2) * kstep; const char* b2 = last ? nB : cB + (size_t)(t + 2) * kstep;
            const char* a3 = a2 + kstep; const char* b3 = b2 + kstep;
            G_LDB(B0, 0, 0); G_LDB(B1, 0, 1); G_SCHED; G_LDA(At, 0, 0); G_STAGE(G_SA(1, 1), a1 + hstepA, voffA);
            G_WAIT_V(8); G_WAIT_L(0); G_BAR; G_MMA(0, 0, At, B0); G_MMA(0, 1, At, B1); G_BAR; G_SCHED;
            G_LDA(At, 0, 1); G_STAGE(G_SB(0, 0), b2, voffB); G_STAGE(G_SB(0, 1), b2 + hstepB, voffB); G_STAGE(G_SA(0, 0), a2, voffA);
            G_WAIT_V(8); G_WAIT_L(0); G_BAR; G_MMA(1, 0, At, B0); G_MMA(1, 1, At, B1); G_BAR; G_SCHED;
            G_LDB(B0, 1, 0); G_LDB(B1, 1, 1); G_SCHED; G_LDA(At, 1, 0); G_STAGE(G_SA(0, 1), a2 + hstepA, voffA);
            G_WAIT_V(8); G_WAIT_L(0); G_BAR; G_MMA(0, 0, At, B0); G_MMA(0, 1, At, B1); G_BAR; G_SCHED;
            G_LDA(At, 1, 1); G_STAGE(G_SB(1, 0), b3, voffB); G_STAGE(G_SB(1, 1), b3 + hstepB, voffB); G_STAGE(G_SA(1, 0), a3, voffA);
            G_WAIT_V(8); G_WAIT_L(0); G_BAR; G_MMA(1, 0, At, B0); G_MMA(1, 1, At, B1); G_BAR; G_SCHED;
        }
        if (NSTORE != 0 && wr == 0) G_BAR;
#pragma unroll
        for (int ai = 0; ai < 2; ++ai)
#pragma unroll
            for (int m = 0; m < 4; ++m)
#pragma unroll
                for (int bj = 0; bj < 2; ++bj)
                    emit(brow + ai * HALF + wr * 64 + m * 16 + fr, bcol + bj * HALF + wc * 32 + fq * 8, acc[ai][bj][m][0], acc[ai][bj][m][1]);
        if (!has_next) break;
#pragma unroll
        for (int a = 0; a < 2; ++a)
#pragma unroll
            for (int b = 0; b < 2; ++b)
#pragma unroll
                for (int m = 0; m < 4; ++m)
#pragma unroll
                    for (int n = 0; n < 2; ++n) acc[a][b][m][n] = (f32x4){0.f, 0.f, 0.f, 0.f};
        brow = nrow; bcol = ncol; cA = nA; cB = nB; ++ui;
        if (NSTORE != 0 && wr == 1) G_BAR;
    }
    G_WAIT_V(0);
    if (NSTORE == 0 && wr == 0) G_BAR;
    G_BAR;
#undef G_SA
#undef G_SB
#undef G_STAGE
#undef G_LDA
#undef G_LDB
#undef G_MMA
}

DEVI void tile_map(int L, int nM, int nN, int& pm, int& pn) {
    const int nwg = nM * nN;
    int wgid = L;
    { const int q = nwg / 8, r = nwg % 8, xcd = wgid % 8, off = wgid / 8; wgid = (xcd < r ? xcd * (q + 1) : r * (q + 1) + (xcd - r) * q) + off; }
    const int nig = 8 * nN, gid = wgid / nig, fm = gid * 8, gsz = (nM - fm) < 8 ? (nM - fm) : 8;
    pm = fm + ((wgid % nig) % gsz); pn = (wgid % nig) / gsz;
}

template <int KW, class F>
DEVI void gemm_small(const bf16_t* __restrict__ A, int lda, const bf16_t* __restrict__ Bt, int ldb, int K, int row0, int col0, float* lds, F&& emit) {
    constexpr int RW = 8 / KW, MT16 = 4 / RW;
    const int tid = get_tid(), wv = tid >> 6, lane = tid & 63, fr = lane & 15, fq = lane >> 4;
    const int kq = wv % KW, rh = wv / KW;
    const int ks = K / KW, kbeg = kq * ks;
    f32x4 acc[MT16][4];
#pragma unroll
    for (int m = 0; m < MT16; ++m)
#pragma unroll
        for (int n = 0; n < 4; ++n) acc[m][n] = (f32x4){0.f, 0.f, 0.f, 0.f};
    const bf16_t* ap = A + (size_t)(row0 + rh * (64 / RW) + fr) * lda + kbeg + 8 * fq;
    const bf16_t* bp = Bt + (size_t)(col0 + 8 * (fr >> 2) + (fr & 3)) * ldb + kbeg + 8 * fq;
#pragma unroll 4
    for (int k = 0; k < ks; k += 32) {
        bf16x8 af[MT16], bfr[4];
#pragma unroll
        for (int m = 0; m < MT16; ++m) af[m] = *(const bf16x8*)(ap + (size_t)(m * 16) * lda + k);
#pragma unroll
        for (int n = 0; n < 4; ++n) bfr[n] = *(const bf16x8*)(bp + (size_t)((n >> 1) * 32 + (n & 1) * 4) * ldb + k);
#pragma unroll
        for (int m = 0; m < MT16; ++m)
#pragma unroll
            for (int n = 0; n < 4; ++n) acc[m][n] = __builtin_amdgcn_mfma_f32_16x16x32_bf16(bfr[n], af[m], acc[m][n], 0, 0, 0);
    }
    __syncthreads();
    float* slab = lds + kq * 4096;
#pragma unroll
    for (int m = 0; m < MT16; ++m)
#pragma unroll
        for (int n = 0; n < 4; ++n) {
            const int row = rh * (64 / RW) + m * 16 + fr, grp = ((n >> 1) * 8 + 2 * fq + (n & 1)) ^ (row & 15);
            *(f32x4*)(slab + row * 64 + grp * 4) = acc[m][n];
        }
    __syncthreads();
    {
        const int row = tid >> 3, c = tid & 7, g0 = c * 2, g1 = g0 + 1;
        f32x4 v0 = {0.f, 0.f, 0.f, 0.f}, v1 = {0.f, 0.f, 0.f, 0.f};
#pragma unroll
        for (int w = 0; w < KW; ++w) {
            v0 += *(const f32x4*)(lds + w * 4096 + row * 64 + ((g0 ^ (row & 15)) * 4));
            v1 += *(const f32x4*)(lds + w * 4096 + row * 64 + ((g1 ^ (row & 15)) * 4));
        }
        emit(row0 + row, col0 + g0 * 4, v0, v1);
    }
    __syncthreads();
}

DEVI void st_bf16x8(bf16_t* p, f32x4 a, f32x4 b) { u32x4 w; w.x = pk2(a[0], a[1]); w.y = pk2(a[2], a[3]); w.z = pk2(b[0], b[1]); w.w = pk2(b[2], b[3]); *(u32x4*)p = w; }

struct TJob { const float* src; bf16_t* dst; int K, N, Npad, src_ld; float scale; int scale_cols; const float* kgain; };
DEVI bool get_tjob(const Params& p, int j, TJob& t) {
    unsigned char* ws = p.ws;
    switch (j) {
    case 0: t = {p.in[11], (bf16_t*)(ws + WS_W1T), 1024, 3072, 3072, 3072, SBQ, 512, p.in[7]}; return true;
    case 1: t = {p.in[13], (bf16_t*)(ws + WS_WO1T), 1024, 1024, 1024, 1024, 1.f, 0, nullptr}; return true;
    case 2: t = {p.in[25], (bf16_t*)(ws + WS_WUP0), 1024, 4096, 4096, 4096, 1.f, 0, p.in[9]}; return true;
    case 3: t = {p.in[25] + 1024ull * 4096, (bf16_t*)(ws + WS_WUP1), 1024, 4096, 4096, 4096, 1.f, 0, p.in[9] + 1024}; return true;
    case 4: t = {p.in[26], (bf16_t*)(ws + WS_WDN0), 4096, 1024, 1024, 1024, 1.f, 0, nullptr}; return true;
    case 5: t = {p.in[26] + 1024ull * 4096, (bf16_t*)(ws + WS_WDN1), 4096, 1024, 1024, 1024, 1.f, 0, nullptr}; return true;
    case 6: t = {p.in[14], (bf16_t*)(ws + WS_W2T), 1024, 1696, 1792, 1696, 1.f, 0, p.in[7] + 1024}; return true;
    case 7: t = {p.in[21], (bf16_t*)(ws + WS_WUQT), 384, 768, 768, 768, MLQ, 768, nullptr}; return true;
    case 8: t = {p.in[24], (bf16_t*)(ws + WS_WO2T), 1024, 1024, 1024, 1024, 1.f, 0, nullptr}; return true;
    default:
        if (j < 17) { int h = j - 9; t = {p.in[23] + (size_t)h * 256 * 64, (bf16_t*)(ws + WS_WKVT) + (size_t)(512 + h * 64) * 256, 256, 64, 64, 64, 1.f, 0, nullptr}; return true; }
        return false;
    }
}

DEVI void phase_prep(const Params& p, float* lds) {
    const int tid = get_tid();
    int base = 0;
    for (int j = 0; j < 17; ++j) {
        TJob t; get_tjob(p, j, t);
        const int tk = t.K / 64, tn = t.Npad / 64, ntile = tk * tn;
        int first = ((int)blockIdx.x - base % (int)gridDim.x + (int)gridDim.x) % (int)gridDim.x;
        for (int i = first; i < ntile; i += gridDim.x) {
            const int k0 = (i % tk) * 64, n0 = (i / tk) * 64;
            __syncthreads();
#pragma unroll
            for (int e = 0; e < 2; ++e) {
                const int idx = tid + e * 512, kk = idx >> 4, n4 = (idx & 15) * 4, n = n0 + n4;
                f32x4 v = {0.f, 0.f, 0.f, 0.f};
                if (n < t.N) { v = *(const f32x4*)(t.src + (size_t)(k0 + kk) * t.src_ld + n); if (n < t.scale_cols) v = v * t.scale; if (t.kgain) v = v * t.kgain[k0 + kk]; }
                lds[kk * 65 + n4] = v[0]; lds[kk * 65 + n4 + 1] = v[1]; lds[kk * 65 + n4 + 2] = v[2]; lds[kk * 65 + n4 + 3] = v[3];
            }
            __syncthreads();
            {
                const int nn = tid >> 3, kc = tid & 7;
                float o[8];
#pragma unroll
                for (int j = 0; j < 8; ++j) o[j] = lds[(kc * 8 + j) * 65 + nn];
                *(u32x4*)(t.dst + (size_t)(n0 + nn) * t.K + k0 + kc * 8) = pack8(o);
            }
        }
        base += ntile;
    }
    const int gtid = blockIdx.x * 512 + tid, gsz = gridDim.x * 512;
    {
        bf16_t* dst = (bf16_t*)(p.ws + WS_WKVT);
        const float* src = p.in[22];
        for (int i = gtid; i < 512 * 256; i += gsz) dst[i] = f2bf(src[i]);
    }
    {
        bf16_t* dst = (bf16_t*)(p.ws + WS_WQLT);
        const float* wuq = p.in[21];
        const float* wuk = p.in[22];
        for (int i = gtid; i < 2048 * 384; i += gsz) {
            int c = i & 255, h = (i >> 8) & 7, j = i >> 11;
            const float* a = wuq + (size_t)j * 768 + h * 96;
            const float* b = wuk + (size_t)h * 64 * 256 + c;
            float s = 0.f;
#pragma unroll 8
            for (int n = 0; n < 64; ++n) s += a[n] * b[(size_t)n * 256];
            dst[(size_t)(h * 256 + c) * 384 + j] = f2bf(s * MLQ);
        }
    }
    {
        const int wv = tid >> 6, lane = tid & 63;
        bf16_t* X = (bf16_t*)(p.ws + WS_H);
        float* RS = (float*)(p.ws + WS_RS);
        for (int rowb = (blockIdx.x * 8 + wv) * 2; rowb < MT; rowb += gridDim.x * 16) {
            float v[2][16]; float ss[2] = {0.f, 0.f};
#pragma unroll
            for (int rr = 0; rr < 2; ++rr) {
                const int row = rowb + rr;
                const float* x = row < NP ? p.in[0] + (size_t)row * 1024 : p.in[1] + (size_t)(row - NP) * 1024;
#pragma unroll
                for (int i = 0; i < 2; ++i) {
                    f32x4 a = *(const f32x4*)(x + i * 512 + lane * 8), b = *(const f32x4*)(x + i * 512 + lane * 8 + 4);
#pragma unroll
                    for (int k = 0; k < 4; ++k) { v[rr][i * 8 + k] = a[k]; v[rr][i * 8 + 4 + k] = b[k]; }
                }
            }
#pragma unroll
            for (int rr = 0; rr < 2; ++rr)
#pragma unroll
                for (int k = 0; k < 16; ++k) ss[rr] += v[rr][k] * v[rr][k];
#pragma unroll
            for (int of = 32; of > 0; of >>= 1) { ss[0] += __shfl_xor(ss[0], of); ss[1] += __shfl_xor(ss[1], of); }
#pragma unroll
            for (int rr = 0; rr < 2; ++rr) {
                const float r = rsqrtf(ss[rr] * (1.f / 1024.f) + EPS);
#pragma unroll
                for (int k = 0; k < 16; ++k) v[rr][k] *= r;
#pragma unroll
                for (int i = 0; i < 2; ++i) *(u32x4*)(X + (size_t)(rowb + rr) * 1024 + i * 512 + lane * 8) = pack8(v[rr] + i * 8);
                if (lane == 0) RS[rowb + rr] = r;
            }
        }
    }
}

DEVI void phase_rowpass(const Params& p, bool first, const float* g1, bool final_) {
    const int tid = get_tid(), wv = tid >> 6, lane = tid & 63;
    const bf16_t* O = (const bf16_t*)(p.ws + WS_O);
    bf16_t* X = (bf16_t*)(p.ws + WS_H);
    float* RS = (float*)(p.ws + WS_RS);
    float ga[16];
#pragma unroll
    for (int i = 0; i < 2; ++i)
#pragma unroll
        for (int k = 0; k < 8; ++k) ga[i * 8 + k] = g1[i * 512 + lane * 8 + k];
    for (int rowb = (blockIdx.x * 8 + wv) * 2; rowb < MT; rowb += gridDim.x * 16) {
        float o[2][16], x[2][16];
#pragma unroll
        for (int rr = 0; rr < 2; ++rr) {
            const int row = rowb + rr;
#pragma unroll
            for (int i = 0; i < 2; ++i) {
                unpack8(*(const u32x4*)(O + (size_t)row * 1024 + i * 512 + lane * 8), o[rr] + i * 8);
                if (first) {
                    const float* xin = row < NP ? p.in[0] + (size_t)row * 1024 : p.in[1] + (size_t)(row - NP) * 1024;
                    f32x4 a = *(const f32x4*)(xin + i * 512 + lane * 8), b = *(const f32x4*)(xin + i * 512 + lane * 8 + 4);
#pragma unroll
                    for (int k = 0; k < 4; ++k) { x[rr][i * 8 + k] = a[k]; x[rr][i * 8 + 4 + k] = b[k]; }
                } else unpack8(*(const u32x4*)(X + (size_t)row * 1024 + i * 512 + lane * 8), x[rr] + i * 8);
            }
            if (!first) {
                const float inv = 1.f / RS[row];
#pragma unroll
                for (int k = 0; k < 16; ++k) x[rr][k] *= inv;
            }
        }
        float ss[2] = {0.f, 0.f};
#pragma unroll
        for (int rr = 0; rr < 2; ++rr)
#pragma unroll
            for (int k = 0; k < 16; ++k) ss[rr] += o[rr][k] * o[rr][k];
#pragma unroll
        for (int of = 32; of > 0; of >>= 1) { ss[0] += __shfl_xor(ss[0], of); ss[1] += __shfl_xor(ss[1], of); }
        float s2[2] = {0.f, 0.f};
#pragma unroll
        for (int rr = 0; rr < 2; ++rr) {
            const float r = rsqrtf(ss[rr] * (1.f / 1024.f) + EPS);
#pragma unroll
            for (int k = 0; k < 16; ++k) { float v = x[rr][k] + o[rr][k] * r * ga[k]; x[rr][k] = v; s2[rr] += v * v; }
        }
        if (final_) {
#pragma unroll
            for (int rr = 0; rr < 2; ++rr) {
                float* y = p.out + O_Y + (size_t)(rowb + rr) * 1024;
#pragma unroll
                for (int i = 0; i < 2; ++i) {
                    *(f32x4*)(y + i * 512 + lane * 8) = (f32x4){x[rr][i * 8], x[rr][i * 8 + 1], x[rr][i * 8 + 2], x[rr][i * 8 + 3]};
                    *(f32x4*)(y + i * 512 + lane * 8 + 4) = (f32x4){x[rr][i * 8 + 4], x[rr][i * 8 + 5], x[rr][i * 8 + 6], x[rr][i * 8 + 7]};
                }
            }
        } else {
#pragma unroll
            for (int of = 32; of > 0; of >>= 1) { s2[0] += __shfl_xor(s2[0], of); s2[1] += __shfl_xor(s2[1], of); }
#pragma unroll
            for (int rr = 0; rr < 2; ++rr) {
                const float r2 = rsqrtf(s2[rr] * (1.f / 1024.f) + EPS);
#pragma unroll
                for (int k = 0; k < 16; ++k) x[rr][k] *= r2;
#pragma unroll
                for (int i = 0; i < 2; ++i) *(u32x4*)(X + (size_t)(rowb + rr) * 1024 + i * 512 + lane * 8) = pack8(x[rr] + i * 8);
                if (lane == 0) RS[rowb + rr] = r2;
            }
        }
    }
}

DEVI void rope_consts(int i, float& crev) { crev = __builtin_amdgcn_exp2f(-(float)i * (13.287712379549449f / 16.f)) * 0.15915494309189535f; }
DEVI void rope_sc(int pos, float crev, float& s, float& c) { float rev = (float)pos * crev; rev -= floorf(rev); s = __builtin_amdgcn_sinf(rev); c = __builtin_amdgcn_cosf(rev); }

DEVI void phase_l1rows(const Params& p) {
    const int tid = get_tid(), wv = tid >> 6, lane = tid & 63;
    bf16_t* IN1 = (bf16_t*)(p.ws + WS_R1 + R1_IN1);
    bf16_t* KC = (bf16_t*)(p.ws + WS_KC);
    const float* lng = p.in[15]; const float* lnb = p.in[16]; const float* qg = p.in[19]; const float* kvg = p.in[20];
    float crev; rope_consts(lane & 15, crev);
    float glng[8], glnb[8], gq[8], gkv[8];
#pragma unroll
    for (int k = 0; k < 8; ++k) { glng[k] = lng[lane * 8 + k]; glnb[k] = lnb[lane * 8 + k]; gq[k] = lane < 48 ? qg[lane * 8 + k] : 0.f; gkv[k] = lane < 32 ? kvg[lane * 8 + k] : 0.f; }
    for (int rowb = (blockIdx.x * 8 + wv) * 2; rowb < MT; rowb += gridDim.x * 16) {
        float v[2][8], cq[2][8], kv[2][8], x1[2], x2[2];
#pragma unroll
        for (int rr = 0; rr < 2; ++rr) {
            const bf16_t* r = IN1 + (size_t)(rowb + rr) * 1792;
            unpack8(*(const u32x4*)(r + 512 + lane * 8), v[rr]);
            u32x4 z = {0u, 0u, 0u, 0u};
            unpack8(lane < 48 ? *(const u32x4*)(r + 1024 + lane * 8) : z, cq[rr]);
            unpack8(lane < 32 ? *(const u32x4*)(r + 1408 + lane * 8) : z, kv[rr]);
            x1[rr] = lane < 16 ? bf2f(r[1664 + lane]) : 0.f; x2[rr] = lane < 16 ? bf2f(r[1680 + lane]) : 0.f;
        }
        float sv[2], sq[2], sk[2];
#pragma unroll
        for (int rr = 0; rr < 2; ++rr) {
            sv[rr] = 0.f; sq[rr] = 0.f; sk[rr] = 0.f;
#pragma unroll
            for (int k = 0; k < 8; ++k) { sv[rr] += v[rr][k]; sq[rr] += cq[rr][k] * cq[rr][k]; sk[rr] += kv[rr][k] * kv[rr][k]; }
        }
#pragma unroll
        for (int of = 32; of > 0; of >>= 1)
#pragma unroll
            for (int rr = 0; rr < 2; ++rr) { sv[rr] += __shfl_xor(sv[rr], of); sq[rr] += __shfl_xor(sq[rr], of); sk[rr] += __shfl_xor(sk[rr], of); }
        float var[2];
#pragma unroll
        for (int rr = 0; rr < 2; ++rr) {
            const float mu = sv[rr] * (1.f / 512.f); var[rr] = 0.f;
#pragma unroll
            for (int k = 0; k < 8; ++k) { v[rr][k] -= mu; var[rr] += v[rr][k] * v[rr][k]; }
        }
#pragma unroll
        for (int of = 32; of > 0; of >>= 1) { var[0] += __shfl_xor(var[0], of); var[1] += __shfl_xor(var[1], of); }
#pragma unroll
        for (int rr = 0; rr < 2; ++rr) {
            const int row = rowb + rr;
            bf16_t* r = IN1 + (size_t)row * 1792;
            {
                const float rs = rsqrtf(var[rr] * (1.f / 512.f) + EPS);
#pragma unroll
                for (int k = 0; k < 8; ++k) v[rr][k] = v[rr][k] * rs * glng[k] + glnb[k];
                *(u32x4*)(r + 512 + lane * 8) = pack8(v[rr]);
                if (row >= NP) {
                    float* o = p.out + O_SGUV_S + (size_t)(row - NP) * 512 + lane * 8;
                    *(f32x4*)o = (f32x4){v[rr][0], v[rr][1], v[rr][2], v[rr][3]}; *(f32x4*)(o + 4) = (f32x4){v[rr][4], v[rr][5], v[rr][6], v[rr][7]};
                }
            }
            if (lane < 48) {
                const float rs = rsqrtf(sq[rr] * (1.f / 384.f) + EPS);
#pragma unroll
                for (int k = 0; k < 8; ++k) cq[rr][k] = cq[rr][k] * rs * gq[k];
                *(u32x4*)(r + 1024 + lane * 8) = pack8(cq[rr]);
            }
            if (lane < 32) {
                const float rs = rsqrtf(sk[rr] * (1.f / 256.f) + EPS);
#pragma unroll
                for (int k = 0; k < 8; ++k) kv[rr][k] = kv[rr][k] * rs * gkv[k];
                u32x4 w = pack8(kv[rr]);
                *(u32x4*)(r + 1408 + lane * 8) = w;
                float* o = row < NP ? p.out + O_CKV_P + (size_t)row * 256 + lane * 8 : p.out + O_CKV_S + (size_t)(row - NP) * 256 + lane * 8;
                *(f32x4*)o = (f32x4){kv[rr][0], kv[rr][1], kv[rr][2], kv[rr][3]}; *(f32x4*)(o + 4) = (f32x4){kv[rr][4], kv[rr][5], kv[rr][6], kv[rr][7]};
                if (row >= NP) { int b = (row - NP) >> 4, t = (row - NP) & 15; *(u32x4*)(KC + ((size_t)b * 4112 + 4096 + t) * 288 + lane * 8) = w; }
            }
            if (lane < 16) {
                float sn, c; rope_sc(row_pos(row), crev, sn, c);
                float o1 = x1[rr] * c - x2[rr] * sn, o2 = x1[rr] * sn + x2[rr] * c;
                bf16_t b1 = f2bf(o1), b2 = f2bf(o2);
                r[1664 + lane] = b1; r[1680 + lane] = b2;
                float* o = row < NP ? p.out + O_KPE_P + (size_t)row * 32 : p.out + O_KPE_S + (size_t)(row - NP) * 32;
                o[lane] = o1; o[lane + 16] = o2;
                if (row >= NP) { int b = (row - NP) >> 4, t = (row - NP) & 15; bf16_t* kc = KC + ((size_t)b * 4112 + 4096 + t) * 288 + 256; kc[lane] = b1; kc[lane + 16] = b2; }
            }
        }
    }
}

DEVI void kc_item(const Params& p, int item) {
    const int tid = get_tid();
    bf16_t* KC = (bf16_t*)(p.ws + WS_KC);
    const float* cc = p.in[5]; const float* cp = p.in[6];
#pragma unroll
    for (int e = 0; e < 8; ++e) {
        const long id = (long)item * 4096 + e * 512 + tid;
        const long rw = id / 36; const int ch = (int)(id - rw * 36);
        const int b = (int)(rw >> 12), kk = (int)(rw & 4095);
        const float* src = ch < 32 ? cc + (size_t)rw * 256 + ch * 8 : cp + (size_t)rw * 32 + (ch - 32) * 8;
        f32x4 a = *(const f32x4*)src, bb = *(const f32x4*)(src + 4);
        u32x4 w; w.x = pk2(a[0], a[1]); w.y = pk2(a[2], a[3]); w.z = pk2(bb[0], bb[1]); w.w = pk2(bb[2], bb[3]);
        *(u32x4*)(KC + ((size_t)b * 4112 + kk) * 288 + ch * 8) = w;
    }
}

DEVI void conv_item(const Params& p, int item) {
    const int tid = get_tid(), ch = tid & 63, rs = tid >> 6;
    const bf16_t* Q = (const bf16_t*)(p.ws + WS_R1 + R1_QKVG);
    bf16_t* MX = (bf16_t*)(p.ws + WS_R1 + R1_MIXED);
    const float* wc = p.in[12];
    float w0[8], w1[8], w2[8];
#pragma unroll
    for (int k = 0; k < 8; ++k) { w0[k] = wc[ch * 8 + k]; w1[k] = wc[512 + ch * 8 + k]; w2[k] = wc[1024 + ch * 8 + k]; }
#pragma unroll 1
    for (int i = 0; i < 4; ++i) {
        int rbase = item * 32;
        if (item < 2048) { const int bi = item >> 6; rbase = ((bi & 7) * 4 + (3 - (bi >> 3))) * 2048 + (item & 63) * 32; }
        const int row = rbase + rs + i * 8;
        const bool samp = row >= NP;
        const int t = samp ? (row - NP) & 15 : row & 2047;
        const int b = samp ? (row - NP) >> 4 : row >> 11;
        float cin[3][8];
#pragma unroll
        for (int j = 0; j < 3; ++j) {
            if (t - j >= 0) {
                const bf16_t* rr = Q + (size_t)(row - j) * 3072;
                float a[8], u[8]; unpack8(*(const u32x4*)(rr + 2048 + ch * 8), a); unpack8(*(const u32x4*)(rr + 2560 + ch * 8), u);
#pragma unroll
                for (int k = 0; k < 8; ++k) cin[j][k] = a[k] * u[k];
            } else if (samp) {
                const float* pv = p.in[4] + ((size_t)b * 2 + (2 + t - j)) * 512 + ch * 8;
#pragma unroll
                for (int k = 0; k < 8; ++k) cin[j][k] = pv[k];
            } else {
#pragma unroll
                for (int k = 0; k < 8; ++k) cin[j][k] = 0.f;
            }
        }
        {
            float kf[8], vf[8];
            unpack8(*(const u32x4*)(Q + (size_t)row * 3072 + 512 + ch * 8), kf); unpack8(*(const u32x4*)(Q + (size_t)row * 3072 + 1024 + ch * 8), vf);
            float* ok = p.out + (samp ? O_SBK_S + (size_t)(row - NP) * 512 : O_SBK_P + (size_t)row * 512) + ch * 8;
            float* ov = p.out + (samp ? O_SBV_S + (size_t)(row - NP) * 512 : O_SBV_P + (size_t)row * 512) + ch * 8;
            *(f32x4*)ok = (f32x4){kf[0], kf[1], kf[2], kf[3]}; *(f32x4*)(ok + 4) = (f32x4){kf[4], kf[5], kf[6], kf[7]};
            *(f32x4*)ov = (f32x4){vf[0], vf[1], vf[2], vf[3]}; *(f32x4*)(ov + 4) = (f32x4){vf[4], vf[5], vf[6], vf[7]};
        }
        float gp[8]; unpack8(*(const u32x4*)(Q + (size_t)row * 3072 + 1536 + ch * 8), gp);
        float o[8];
#pragma unroll
        for (int k = 0; k < 8; ++k) o[k] = gp[k] * (w0[k] * cin[2][k] + w1[k] * cin[1][k] + w2[k] * cin[0][k]);
        *(u32x4*)(MX + (size_t)row * 1024 + 512 + ch * 8) = pack8(o);
        const int tl = samp ? 14 : 2046;
        if (t >= tl) {
            float* o2 = p.out + (samp ? O_CONV_S : O_CONV_P) + ((size_t)b * 2 + (t - tl)) * 512 + ch * 8;
#pragma unroll
            for (int k = 0; k < 8; ++k) o2[k] = cin[0][k];
        }
    }
}

DEVI s4v tr_read(const unsigned char* lp) { return __builtin_amdgcn_ds_read_tr16_b64_v4i16((__attribute__((address_space(3))) s4v*)(lp)); }

DEVI void sgu_item(const Params& p, int sg, unsigned char* smem) {
    const int tid = get_tid(), wv = tid >> 6, lane = tid & 63;
    int g, row0, L;
    if (sg < 2048) { const int chunk = sg >> 2; g = sg & 3; row0 = (chunk >> 4) * 2048 + (chunk & 15) * 128; L = 128; }
    else { const int s2 = sg - 2048; g = s2 & 3; row0 = NP + (s2 >> 2) * 16; L = 16; }
    bf16_t* IN1 = (bf16_t*)(p.ws + WS_R1 + R1_IN1);
    bf16_t* MX = (bf16_t*)(p.ws + WS_R1 + R1_MIXED2);
    const float* Wg = p.in[17] + (size_t)g * 128 * 128;
    const float* bs = p.in[18] + g * 128;
    constexpr int STR = 272;
    unsigned char* Wl = smem; unsigned char* Vl = smem + 128 * STR;
#pragma unroll
    for (int e = 0; e < 8; ++e) {
        int idx = tid + e * 512, t = idx >> 5, s4 = (idx & 31) * 4;
        f32x4 w = {0.f, 0.f, 0.f, 0.f};
        if (t < L) w = *(const f32x4*)(Wg + t * 128 + s4);
        float o[4];
#pragma unroll
        for (int k = 0; k < 4; ++k) o[k] = (s4 + k <= t && s4 + k < L) ? w[k] : 0.f;
        u32x2 pw; pw.x = pk2(o[0], o[1]); pw.y = pk2(o[2], o[3]);
        *(u32x2*)(Wl + t * STR + s4 * 2) = pw;
    }
#pragma unroll
    for (int e = 0; e < 4; ++e) {
        int idx = tid + e * 512, s = idx >> 4, c = idx & 15;
        u32x4 w = {0u, 0u, 0u, 0u};
        if (s < L) w = *(const u32x4*)(IN1 + (size_t)(row0 + s) * 1792 + 512 + g * 128 + c * 8);
        *(u32x4*)(Vl + s * STR + c * 16) = w;
    }
    __syncthreads();
    const int tb = wv >> 1, r = lane & 31, h = lane >> 5, grp = lane >> 4, q = (lane & 15) >> 2, pp = lane & 3;
    f32x16 acc[2] = {};
    if (tb * 32 < L) {
        for (int sb = 0; sb <= tb; ++sb) {
#pragma unroll
            for (int st = 0; st < 2; ++st) {
                bf16x8 a = *(const bf16x8*)(Wl + (tb * 32 + r) * STR + (sb * 32 + st * 16 + 8 * h) * 2);
#pragma unroll
                for (int d2 = 0; d2 < 2; ++d2) {
                    const int db = (wv & 1) * 2 + d2;
                    const unsigned char* vp = Vl + (sb * 32 + st * 16 + 8 * h + q) * STR + (db * 32 + 16 * (grp & 1) + 4 * pp) * 2;
                    s4v lo = tr_read(vp), hi = tr_read(vp + 4 * STR);
                    bf16x8 bfr = __builtin_shufflevector(lo, hi, 0, 1, 2, 3, 4, 5, 6, 7);
                    acc[d2] = __builtin_amdgcn_mfma_f32_32x32x16_bf16(a, bfr, acc[d2], 0, 0, 0);
                }
            }
        }
    }
    __syncthreads();
    float* Sl = (float*)smem;
    if (tb * 32 < L) {
#pragma unroll
        for (int d2 = 0; d2 < 2; ++d2) {
            const int d = ((wv & 1) * 2 + d2) * 32 + r;
#pragma unroll
            for (int reg = 0; reg < 16; ++reg) {
                const int t = tb * 32 + (reg & 3) + 8 * (reg >> 2) + 4 * h;
                Sl[t * 132 + d] = acc[d2][reg];
            }
        }
    }
    __syncthreads();
#pragma unroll
    for (int e = 0; e < 4; ++e) {
        const int idx = tid + e * 512, t = idx >> 4, c = idx & 15;
        if (t < L) {
            float u[8]; unpack8(*(const u32x4*)(IN1 + (size_t)(row0 + t) * 1792 + g * 128 + c * 8), u);
            const f32x4 s0 = *(const f32x4*)(Sl + t * 132 + c * 8), s1 = *(const f32x4*)(Sl + t * 132 + c * 8 + 4);
            const float bt = bs[t];
            float o[8];
#pragma unroll
            for (int k = 0; k < 4; ++k) { o[k] = u[k] * (s0[k] + bt); o[4 + k] = u[4 + k] * (s1[k] + bt); }
            *(u32x4*)(MX + (size_t)(row0 + t) * 1024 + g * 128 + c * 8) = pack8(o);
        }
    }
}

template <int MODE> struct AC;
template <> struct AC<0> { static constexpr int DQK = 64, DV = 64, KSTR = 144, VSTR = 144, NST = 2; };
template <> struct AC<1> { static constexpr int DQK = 96, DV = 64, KSTR = 208, VSTR = 192, NST = 3; };
template <> struct AC<2> { static constexpr int DQK = 288, DV = 256, KSTR = 592, VSTR = 592, NST = 5; };
constexpr int SM_V = 40960, SM_FLAG = 65536;

DEVI u32x4 ld_f32x8_bf16(const float* src) {
    f32x4 a = *(const f32x4*)src, b = *(const f32x4*)(src + 4);
    u32x4 w; w.x = pk2(a[0], a[1]); w.y = pk2(a[2], a[3]); w.z = pk2(b[0], b[1]); w.w = pk2(b[2], b[3]); return w;
}

template <int MODE>
DEVI void attn_item(const Params& p, int item, unsigned char* smem) {
    typedef AC<MODE> C;
    constexpr int KS = C::DQK / 16, DB = (MODE == 2) ? 4 : C::DV / 32, NST = C::NST, NQF = (MODE == 2) ? 1 : KS;
    const int tid = get_tid(), wv = tid >> 6, lane = tid & 63;
    const int r = lane & 31, h = lane >> 5, grp = lane >> 4, q4 = (lane & 15) >> 2, pp = lane & 3;
    unsigned char* Ks = smem;
    unsigned char* Vs = (MODE == 2) ? smem : smem + SM_V;
    unsigned char* Qs = smem + SM_V;
    volatile int* flags = (volatile int*)(smem + SM_FLAG);

    int b = 0, hd = 0, q0 = 0, kt_last = 0; bool samp = false;
    if constexpr (MODE == 0) {
        if (item < 2048) { const int bi = item >> 6, qb = 7 - ((item >> 3) & 7); b = (bi & 7) * 4 + (3 - (bi >> 3)); hd = item & 7; q0 = qb * 256; kt_last = (q0 + 255) >> 6; }
        else { const int s = item - 2048; b = s >> 3; hd = s & 7; samp = true; q0 = 4096; kt_last = 64; }
    } else if constexpr (MODE == 1) {
        const int qb = 7 - (item >> 8); b = (item & 255) >> 3; hd = item & 7; q0 = qb * 256; kt_last = (q0 + 255) >> 6;
    } else { b = item; kt_last = 64; }
    const bf16_t* QKVG = (const bf16_t*)(p.ws + WS_R1 + R1_QKVG);
    const bf16_t* IN1 = (const bf16_t*)(p.ws + WS_R1 + R1_IN1);
    const bf16_t* QF = (const bf16_t*)(p.ws + WS_R1 + R1_QF);
    const bf16_t* KVUP = (const bf16_t*)(p.ws + WS_R1 + R1_KVUP);
    const bf16_t* QLAT = (const bf16_t*)(p.ws + WS_R1 + R1_QLAT);
    const bf16_t* KC = (const bf16_t*)(p.ws + WS_KC);

    bool wactive; int qpos = 0; bool qvalid = true; size_t orow = 0;
    bf16x8 qf[NQF];
    const int rg = wv & 3, dvh = (MODE == 2) ? (wv >> 2) : 0;
    if constexpr (MODE == 0) {
        wactive = samp ? (wv == 0) : true;
        int qi = samp ? (r & 15) : (wv * 32 + r);
        qvalid = samp ? (r < 16) : true;
        qpos = q0 + qi;
        orow = samp ? (size_t)(NP + b * 16 + qi) : (size_t)(b * 2048 + q0 + qi);
        const bf16_t* qp = QKVG + orow * 3072 + hd * 64;
#pragma unroll
        for (int st = 0; st < KS; ++st) qf[st] = *(const bf16x8*)(qp + st * 16 + 8 * h);
    } else if constexpr (MODE == 1) {
        wactive = true; qpos = q0 + wv * 32 + r; orow = (size_t)(b * 2048 + qpos);
        const bf16_t* qp = QF + orow * 768 + hd * 96;
#pragma unroll
        for (int st = 0; st < KS; ++st) qf[st] = *(const bf16x8*)(qp + st * 16 + 8 * h);
#pragma unroll
        for (int j = 0; j < 8; ++j) {
            float crev; rope_consts(8 * h + j, crev);
            float sn, cs; rope_sc(qpos, crev, sn, cs);
            const float x1 = bf2f((unsigned short)qf[4][j]), x2 = bf2f((unsigned short)qf[5][j]);
            qf[4][j] = (short)f2bf(x1 * cs - x2 * sn); qf[5][j] = (short)f2bf(x1 * sn + x2 * cs);
        }
    } else {
        wactive = true;
        for (int id = tid; id < 128 * 36; id += 512) {
            const int rr = id / 36, ch = id % 36, hh = rr >> 4, t = rr & 15;
            u32x4 w = ch < 32 ? *(const u32x4*)(QLAT + (size_t)(b * 16 + t) * 2048 + hh * 256 + ch * 8)
                              : *(const u32x4*)(QF + (size_t)(NP + b * 16 + t) * 768 + hh * 96 + 64 + (ch - 32) * 8);
            *(u32x4*)(Qs + rr * 592 + ch * 16) = w;
        }
        __syncthreads();
        for (int id = tid; id < 128 * 16; id += 512) {
            const int rr = id >> 4, i = id & 15, t = rr & 15;
            bf16_t* qrow = (bf16_t*)(Qs + rr * 592);
            float crev; rope_consts(i, crev);
            float sn, cs; rope_sc(4096 + t, crev, sn, cs);
            const float x1 = bf2f(qrow[256 + i]), x2 = bf2f(qrow[272 + i]);
            qrow[256 + i] = f2bf(x1 * cs - x2 * sn); qrow[272 + i] = f2bf(x1 * sn + x2 * cs);
        }
    }
    const int wave_qmax = q0 + wv * 32 + 31;
    const int wave_chunk = (q0 + wv * 32) >> 6;

    f32x16 O[DB];
#pragma unroll
    for (int d = 0; d < DB; ++d) O[d] = (f32x16){};
    float carry = (MODE == 0) ? 1.f : 0.f, mrun = -INFINITY, lrun = 0.f;

    constexpr int NH = (MODE == 2) ? 1 : 2;
    u32x4 stg[NH][NST];
    auto issue = [&](int kT) {
#pragma unroll
        for (int hf = 0; hf < NH; ++hf) {
            const int kt = kT * NH + hf;
#pragma unroll
            for (int i = 0; i < NST; ++i) {
                u32x4 w = {0u, 0u, 0u, 0u};
                if constexpr (MODE == 0) {
                    const int row = tid >> 3, ch = tid & 7, kk = kt * 64 + row;
                    const int off = (i == 0 ? 512 : 1024) + hd * 64 + ch * 8;
                    if (!samp) w = *(const u32x4*)(QKVG + (size_t)(b * 2048 + kk) * 3072 + off);
                    else if (kk < 4096) w = ld_f32x8_bf16(p.in[i == 0 ? 2 : 3] + (((size_t)b * 4096 + kk) * 8 + hd) * 64 + ch * 8);
                    else if (kk < 4112) w = *(const u32x4*)(QKVG + (size_t)(NP + b * 16 + kk - 4096) * 3072 + off);
                } else if constexpr (MODE == 1) {
                    if (i == 0) { const int row = tid >> 3, ch = tid & 7; w = *(const u32x4*)(KVUP + (size_t)(b * 2048 + kt * 64 + row) * 1024 + 512 + hd * 64 + ch * 8); }
                    else {
                        const int id = tid + (i - 1) * 512;
                        if (id < 768) { const int row = id / 12, ch = id % 12; const size_t gr = (size_t)(b * 2048 + kt * 64 + row);
                            w = ch < 8 ? *(const u32x4*)(KVUP + gr * 1024 + hd * 64 + ch * 8) : *(const u32x4*)(IN1 + gr * 1792 + 1664 + (ch - 8) * 8); }
                    }
                } else {
                    const int id = tid + i * 512;
                    if (id < 2304) { const int row = id / 36, ch = id % 36, kk = kt * 64 + row;
                        if (kk < 4112) w = *(const u32x4*)(KC + ((size_t)b * 4112 + kk) * 288 + ch * 8); }
                }
                stg[hf][i] = w;
            }
        }
    };
    auto commit = [&]() {
#pragma unroll
        for (int hf = 0; hf < NH; ++hf) {
            unsigned char* Kh = Ks + hf * 64 * C::KSTR; unsigned char* Vh = Vs + hf * 64 * C::VSTR;
#pragma unroll
            for (int i = 0; i < NST; ++i) {
                if constexpr (MODE == 0) { const int row = tid >> 3, ch = tid & 7; *(u32x4*)((i == 0 ? Kh + row * C::KSTR : Vh + row * C::VSTR) + ch * 16) = stg[hf][i]; }
                else if constexpr (MODE == 1) {
                    if (i == 0) { const int row = tid >> 3, ch = tid & 7; *(u32x4*)(Vh + row * C::VSTR + ch * 16) = stg[hf][0]; }
                    else { const int id = tid + (i - 1) * 512; if (id < 768) { const int row = id / 12, ch = id % 12; *(u32x4*)(Kh + row * C::KSTR + ch * 16) = stg[hf][i]; } }
                } else { const int id = tid + i * 512; if (id < 2304) { const int row = id / 36, ch = id % 36; *(u32x4*)(Kh + row * C::KSTR + ch * 16) = stg[hf][i]; } }
            }
        }
    };

    const int kT_last = kt_last / NH;
    issue(kT_last);
    int done = wactive ? 0 : 1, par = 0;
    for (int kT = kT_last; kT >= 0; --kT) {
        if constexpr (MODE == 0) { if (lane == 0) flags[par * 8 + wv] = done; }
        __syncthreads();
        if constexpr (MODE == 0) {
            int all = 1;
#pragma unroll
            for (int w = 0; w < 8; ++w) all &= flags[par * 8 + w];
            par ^= 1;
            if (all) break;
        }
        commit();
        __syncthreads();
        if (kT > 0) issue(kT - 1);
      f32x16 SA[NH][2]; bool relq[NH];
#pragma unroll
      for (int hfi = 0; hfi < NH; ++hfi) {
        const int hf = NH - 1 - hfi, kt = kT * NH + hf;
        unsigned char* Ks = smem + hf * 64 * C::KSTR;
        bool rel = wactive && (kt <= kt_last);
        if constexpr (MODE == 0) rel = rel && !done && (samp || kt * 64 < wave_qmax);
        if constexpr (MODE == 1) rel = rel && (kt <= wave_chunk);
        relq[hf] = rel;
        SA[hf][0] = (f32x16){}; SA[hf][1] = (f32x16){};
        if (rel) {
                constexpr int CH = (KS % 6 == 0) ? 6 : 4;
#pragma unroll
                for (int c0 = 0; c0 < KS; c0 += CH) {
                    bf16x8 ka[2][CH], qb[CH];
#pragma unroll
                    for (int s = 0; s < CH; ++s) {
                        ka[0][s] = *(const bf16x8*)(Ks + (r) * C::KSTR + ((c0 + s) * 16 + 8 * h) * 2);
                        ka[1][s] = *(const bf16x8*)(Ks + (32 + r) * C::KSTR + ((c0 + s) * 16 + 8 * h) * 2);
                        if constexpr (MODE == 2) qb[s] = *(const bf16x8*)(Qs + (rg * 32 + r) * 592 + ((c0 + s) * 16 + 8 * h) * 2); else qb[s] = qf[c0 + s];
                    }
                    __builtin_amdgcn_sched_barrier(0);
#pragma unroll
                    for (int s = 0; s < CH; ++s) {
                        SA[hf][0] = __builtin_amdgcn_mfma_f32_32x32x16_bf16(ka[0][s], qb[s], SA[hf][0], 0, 0, 0);
                        SA[hf][1] = __builtin_amdgcn_mfma_f32_32x32x16_bf16(ka[1][s], qb[s], SA[hf][1], 0, 0, 0);
                    }
                }
        }
      }
#pragma unroll
      for (int hfi = 0; hfi < NH; ++hfi) {
        const int hf = NH - 1 - hfi, kt = kT * NH + hf;
        unsigned char* Vs = ((MODE == 2) ? smem : smem + SM_V) + hf * 64 * C::VSTR;
        bool rel = relq[hf];
        if constexpr (MODE == 0) rel = rel && !done;
        if (rel) {
            f32x16 (&S)[2] = SA[hf];
            bf16x8 pf[2][2];
            if constexpr (MODE == 0) {
#pragma unroll
                for (int kbi = 0; kbi < 2; ++kbi) {
                    const int kb = 1 - kbi;
                    float bt[16], qv[16];
#pragma unroll
                    for (int reg = 0; reg < 16; ++reg) {
                        const int kk = kt * 64 + kb * 32 + (reg & 3) + 8 * (reg >> 2) + 4 * h;
                        const bool v = qvalid && (kk < qpos);
                        const float t = __builtin_amdgcn_exp2f(fminf(S[kb][reg], 120.f));
                        const float q = __builtin_amdgcn_rcpf(1.f + t);
                        bt[reg] = v ? t * q : 0.f; qv[reg] = v ? q : 1.f;
                    }
                    float G[4], PG[4], T[4];
#pragma unroll
                    for (int g = 0; g < 4; ++g) { G[g] = (qv[4 * g] * qv[4 * g + 1]) * (qv[4 * g + 2] * qv[4 * g + 3]); PG[g] = __shfl_xor(G[g], 32); }
                    T[3] = 1.f; T[2] = G[3] * PG[3]; T[1] = T[2] * (G[2] * PG[2]); T[0] = T[1] * (G[1] * PG[1]);
                    const float total = T[0] * (G[0] * PG[0]);
                    float w[16];
#pragma unroll
                    for (int g = 0; g < 4; ++g) {
                        float run = carry * T[g] * (h == 0 ? PG[g] : 1.f);
#pragma unroll
                        for (int i = 3; i >= 0; --i) {
                            const int reg = 4 * g + i;
                            w[reg] = bt[reg] * run;
                            run *= qv[reg];
                        }
                    }
                    carry *= total;
#pragma unroll
                    for (int s = 0; s < 2; ++s) {
                        u32x4 u; u.x = pk2(w[8 * s], w[8 * s + 1]); u.y = pk2(w[8 * s + 2], w[8 * s + 3]); u.z = pk2(w[8 * s + 4], w[8 * s + 5]); u.w = pk2(w[8 * s + 6], w[8 * s + 7]);
                        pf[kb][s] = __builtin_bit_cast(bf16x8, u);
                    }
                }
                done = __all((!qvalid) || (carry < 1e-36f)) ? 1 : 0;
            } else {
                float mx = -INFINITY;
#pragma unroll
                for (int kb = 0; kb < 2; ++kb)
#pragma unroll
                    for (int reg = 0; reg < 16; ++reg) {
                        if constexpr (MODE == 2) { const int kk = kt * 64 + kb * 32 + (reg & 3) + 8 * (reg >> 2) + 4 * h; if (kk >= 4112) S[kb][reg] = -INFINITY; }
                        mx = fmaxf(mx, S[kb][reg]);
                    }
                mx = fmaxf(mx, __shfl_xor(mx, 32));
                const float mn = fmaxf(mrun, mx);
                const float alpha = __builtin_amdgcn_exp2f(mrun - mn);
                mrun = mn;
                float ls = 0.f;
#pragma unroll
                for (int kb = 0; kb < 2; ++kb) {
                    float w[16];
#pragma unroll
                    for (int reg = 0; reg < 16; ++reg) { w[reg] = __builtin_amdgcn_exp2f(S[kb][reg] - mn); ls += w[reg]; }
#pragma unroll
                    for (int s = 0; s < 2; ++s) {
                        u32x4 u; u.x = pk2(w[8 * s], w[8 * s + 1]); u.y = pk2(w[8 * s + 2], w[8 * s + 3]); u.z = pk2(w[8 * s + 4], w[8 * s + 5]); u.w = pk2(w[8 * s + 6], w[8 * s + 7]);
                        pf[kb][s] = __builtin_bit_cast(bf16x8, u);
                    }
                }
                lrun = lrun * alpha + ls;
                if (!__all(alpha == 1.f)) {
#pragma unroll
                    for (int d = 0; d < DB; ++d) O[d] = O[d] * alpha;
                }
            }
#pragma unroll
            for (int d = 0; d < DB; ++d) {
                bf16x8 va[2][2];
#pragma unroll
                for (int kb = 0; kb < 2; ++kb)
#pragma unroll
                    for (int s = 0; s < 2; ++s) {
                        const unsigned char* vp = Vs + (kb * 32 + 16 * s + 4 * h + q4) * C::VSTR + ((dvh * 4 + d) * 32 + 16 * (grp & 1) + 4 * pp) * 2;
                        s4v lo = tr_read(vp), hi = tr_read(vp + 8 * C::VSTR);
                        va[kb][s] = __builtin_shufflevector(lo, hi, 0, 1, 2, 3, 4, 5, 6, 7);
                    }
                __builtin_amdgcn_sched_barrier(0);
#pragma unroll
                for (int kb = 0; kb < 2; ++kb)
#pragma unroll
                    for (int s = 0; s < 2; ++s) O[d] = __builtin_amdgcn_mfma_f32_32x32x16_bf16(va[kb][s], pf[kb][s], O[d], 0, 0, 0);
            }
        }
      }
    }
    if (MODE == 0 || MODE == 1) {
        float inv = 1.f;
        if constexpr (MODE == 1) { const float l = lrun + __shfl_xor(lrun, 32); inv = 1.f / l; }
        if (wactive && qvalid) {
            bf16_t* op = (MODE == 0) ? (bf16_t*)(p.ws + WS_R1 + R1_MIXED) + orow * 1024 + hd * 64
                                     : (bf16_t*)(p.ws + WS_R1 + R1_MIXED2) + orow * 1024 + 512 + hd * 64;
#pragma unroll
            for (int d = 0; d < DB; ++d)
#pragma unroll
                for (int g = 0; g < 4; ++g) {
                    u32x2 w; w.x = pk2(O[d][4 * g] * inv, O[d][4 * g + 1] * inv); w.y = pk2(O[d][4 * g + 2] * inv, O[d][4 * g + 3] * inv);
                    *(u32x2*)(op + d * 32 + 8 * g + 4 * h) = w;
                }
        }
    } else {
        const float l = lrun + __shfl_xor(lrun, 32);
        const float inv = 1.f / l;
        __syncthreads();
        float* OL = (float*)smem;
        if (wactive) {
            const int rr = rg * 32 + r;
#pragma unroll
            for (int d = 0; d < DB; ++d)
#pragma unroll
                for (int g = 0; g < 4; ++g)
                    *(f32x4*)(OL + rr * 256 + (dvh * 4 + d) * 32 + 8 * g + 4 * h) = (f32x4){O[d][4 * g] * inv, O[d][4 * g + 1] * inv, O[d][4 * g + 2] * inv, O[d][4 * g + 3] * inv};
        }
        __syncthreads();
        const int hh = tid >> 6, v = tid & 63;
        const float* wuv = p.in[23] + (size_t)hh * 256 * 64 + v;
        float acc[16];
#pragma unroll
        for (int t = 0; t < 16; ++t) acc[t] = 0.f;
        for (int c = 0; c < 256; ++c) {
            const float w = wuv[(size_t)c * 64];
#pragma unroll
            for (int t = 0; t < 16; ++t) acc[t] += OL[(hh * 16 + t) * 256 + c] * w;
        }
        bf16_t* MX = (bf16_t*)(p.ws + WS_R1 + R1_MIXED2);
#pragma unroll
        for (int t = 0; t < 16; ++t) MX[(size_t)(NP + b * 16 + t) * 1024 + 512 + hh * 64 + v] = f2bf(acc[t]);
    }
}

#define XB_TMO      128
#define XB_XCNT(j)  (256  + 64 * (j))
#define XB_XSUB(j)  (1280 + 64 * (j))
#define XB_XGEN(j)  (2304 + 64 * (j))
#define XB_TOP      3328
#define XB_TOPGEN   3392
#define XCD_BAR_WORDS 3456
#define XB_SPIN_CAP (1u << 21)
DEVI unsigned xb_ld(unsigned* p)              { return __hip_atomic_load(p, __ATOMIC_RELAXED, __HIP_MEMORY_SCOPE_AGENT); }
DEVI unsigned xb_add(unsigned* p, unsigned v) { return __hip_atomic_fetch_add(p, v, __ATOMIC_RELAXED, __HIP_MEMORY_SCOPE_AGENT); }
DEVI unsigned xb_xcc_id() { return (unsigned)__builtin_amdgcn_s_getreg((3 << 11) | 20) & 0xFu; }
#define XB_SPIN(cond, bar) do { unsigned _sp = 0; while (cond) { __builtin_amdgcn_s_sleep(1); \
    if ((++_sp & 255u) == 0u) { if (xb_ld(&(bar)[XB_TMO])) break; if (_sp > XB_SPIN_CAP) { atomicAdd(&(bar)[XB_TMO], 1u); break; } } } } while (0)
struct XcdBarrier { unsigned* bar; unsigned x; volatile LAS unsigned* st; };
DEVI XcdBarrier xcd_barrier_post(unsigned* bar, volatile LAS unsigned* st) {
    XcdBarrier b; b.bar = bar; b.x = xb_xcc_id(); b.st = st;
    if (threadIdx.x == 0) (void)xb_add(&bar[XB_XCNT(b.x)], 1u);
    return b;
}
DEVI void xcd_barrier_complete(unsigned* bar, unsigned x, unsigned& nloc, unsigned& nx) {
    const unsigned G = gridDim.x * gridDim.y * gridDim.z;
    unsigned sum, cnt, mine, sp = 0u;
    for (;;) {
        sum = 0u; cnt = 0u; mine = 0u;
#pragma unroll
        for (unsigned j = 0; j < 16; ++j) { const unsigned c = xb_ld(&bar[XB_XCNT(j)]); sum += c; cnt += (c > 0u) ? 1u : 0u; mine = (j == x) ? c : mine; }
        if (sum == G) break;
        __builtin_amdgcn_s_sleep(1);
        if ((++sp & 255u) == 0u) { if (xb_ld(&bar[XB_TMO])) break; if (sp > XB_SPIN_CAP) { atomicAdd(&bar[XB_TMO], 1u); break; } }
    }
    nloc = mine > 0u ? mine : 1u; nx = cnt > 0u ? cnt : 1u;
}
DEVI void xcd_barrier(const XcdBarrier& b) {
    asm volatile("s_waitcnt vmcnt(0)" ::: "memory");
    __syncthreads();
    if (threadIdx.x == 0) {
        unsigned* bar = b.bar;
        __builtin_amdgcn_s_waitcnt(0);
        unsigned nloc = b.st[0], nx = b.st[1];
        if (nloc == 0u) { xcd_barrier_complete(bar, b.x, nloc, nx); b.st[0] = nloc; b.st[1] = nx; }
        const unsigned old = xb_add(&bar[XB_XSUB(b.x)], 1u);
        const unsigned gen = old / nloc;
        if (old + 1u == (gen + 1u) * nloc) {
            __builtin_amdgcn_fence(__ATOMIC_RELEASE, "agent");
            asm volatile("s_waitcnt vmcnt(0)" ::: "memory");
            const unsigned og = xb_add(&bar[XB_TOP], 1u);
            const unsigned tg = og / nx;
            if (og + 1u == (tg + 1u) * nx) xb_add(&bar[XB_TOPGEN], 1u);
            else XB_SPIN(xb_ld(&bar[XB_TOPGEN]) == tg, bar);
            __builtin_amdgcn_fence(__ATOMIC_ACQUIRE, "agent");
            xb_add(&bar[XB_XGEN(b.x)], 1u);
            asm volatile("s_waitcnt vmcnt(0)" ::: "memory");
        } else {
            XB_SPIN(xb_ld(&bar[XB_XGEN(b.x)]) == gen, bar);
            __builtin_amdgcn_fence(__ATOMIC_ACQUIRE, "agent");
            asm volatile("s_waitcnt vmcnt(0)" ::: "memory");
        }
    }
    __syncthreads();
}

DEVI int next_item(unsigned* ctr, int* slot) {
    __syncthreads();
    if (threadIdx.x == 0) *slot = (int)atomicAdd(ctr, 1u);
    __syncthreads();
    return *slot;
}

__global__ void __launch_bounds__(512) mega(Params p, int ph_lo, int ph_hi, int coop) {
    __shared__ __attribute__((aligned(16))) unsigned char smem[131072 + 64];
    int* const s_item_p = (int*)(smem + 131072);
    unsigned* const xbw = (unsigned*)(smem + 131072 + 16);
    if (threadIdx.x == 0) { xbw[0] = 0u; xbw[1] = 0u; xbw[2] = 0u; xbw[3] = 0u; }
    __syncthreads();
    XcdBarrier xb = xcd_barrier_post((unsigned*)(p.ws + WS_CTR), (volatile LAS unsigned*)xbw);
    unsigned* ctr = (unsigned*)(p.ws + WS_CTR);
    bf16_t* shm = (bf16_t*)smem;
    unsigned char* ws = p.ws;
    bf16_t* H = (bf16_t*)(ws + WS_H);
    bf16_t* Ob = (bf16_t*)(ws + WS_O);
    bf16_t* R1 = (bf16_t*)(ws + WS_R1);

    for (int ph = ph_lo; ph < ph_hi; ++ph) {
        if (ph > ph_lo && coop) { if (ph == 1) cg::this_grid().sync(); else xcd_barrier(xb); }
        const int layer = ph >= 8 ? 1 : 0;
        constexpr int rep = 0;
        switch (ph) {
        case 0: phase_prep(p, (float*)smem); break;
        case 1: {
            bf16_t* Q = R1;
            const bf16_t* W = (const bf16_t*)(ws + WS_W1T);
            auto emit = [&](int row, int col, f32x4 v0, f32x4 v1) { bf16_t* d = Q + (size_t)row * 3072 + col; st_bf16x8(d, v0, v1); };
            gemm_run<16>(H, 1024, W, 1024, 1024, shm, [&](int i, int& br, int& bc) { const int it = blockIdx.x + i * gridDim.x; if (it >= 256 * 12) return false; int pm, pn; tile_map(it, 256, 12, pm, pn); br = pm * 256; bc = pn * 256; return true; }, emit);
            for (int it = blockIdx.x; it < 8 * 48; it += gridDim.x) gemm_small<8>(H, 1024, W, 1024, 1024, NP + (it & 7) * 64, (it >> 3) * 64, (float*)smem, emit);
        } break;
        case 2: {
            for (;;) {
                const int it = next_item(ctr + 0 + 2 * rep, s_item_p);
                if (it >= 2304 + 2064 + 1152) break;
                if (it >= 2304 + 2064) { kc_item(p, it - (2304 + 2064)); continue; }
                if (it < 2 * 2064) { if (it & 1) conv_item(p, it >> 1); else attn_item<0>(p, it >> 1, smem); }
                else attn_item<0>(p, it - 2064, smem);
            }
        } break;
        case 3: case 12: {
            const bf16_t* A = R1 + (layer ? R1_MIXED2 : R1_MIXED) / 2;
            const bf16_t* W = (const bf16_t*)(ws + (layer ? WS_WO2T : WS_WO1T));
            auto emit = [&](int row, int col, f32x4 v0, f32x4 v1) { bf16_t* d = Ob + (size_t)row * 1024 + col; st_bf16x8(d, v0, v1); };
            gemm_run<16>(A, 1024, W, 1024, 1024, shm, [&](int i, int& br, int& bc) { const int it = blockIdx.x + i * gridDim.x; if (it >= 256 * 4) return false; int pm, pn; tile_map(it, 256, 4, pm, pn); br = pm * 256; bc = pn * 256; return true; }, emit);
            for (int it = blockIdx.x; it < 8 * 16; it += gridDim.x) gemm_small<8>(A, 1024, W, 1024, 1024, NP + (it & 7) * 64, (it >> 3) * 64, (float*)smem, emit);
        } break;
        case 4: phase_rowpass(p, true, p.in[8], false); break;
        case 13: phase_rowpass(p, false, p.in[8] + 1024, false); break;
        case 5: case 14: {
            bf16_t* ACT = R1;
            const bf16_t* W = (const bf16_t*)(ws + (layer ? WS_WUP1 : WS_WUP0));
            auto emit = [&](int row, int col, f32x4 v0, f32x4 v1) {
#pragma unroll
                for (int k = 0; k < 4; ++k) { float a = fmaxf(v0[k], 0.f), b2 = fmaxf(v1[k], 0.f); v0[k] = a * a; v1[k] = b2 * b2; }
                bf16_t* d = ACT + (size_t)row * 4096 + col; st_bf16x8(d, v0, v1);
            };
            gemm_run<16>(H, 1024, W, 1024, 1024, shm, [&](int i, int& br, int& bc) { const int it = blockIdx.x + i * gridDim.x; if (it >= 256 * 16) return false; int pm, pn; tile_map(it, 256, 16, pm, pn); br = pm * 256; bc = pn * 256; return true; }, emit);
            for (int it = blockIdx.x; it < 8 * 64; it += gridDim.x) gemm_small<8>(H, 1024, W, 1024, 1024, NP + (it & 7) * 64, (it >> 3) * 64, (float*)smem, emit);
        } break;
        case 6: case 15: {
            const bf16_t* ACT = R1;
            const bf16_t* W = (const bf16_t*)(ws + (layer ? WS_WDN1 : WS_WDN0));
            auto emit = [&](int row, int col, f32x4 v0, f32x4 v1) { bf16_t* d = Ob + (size_t)row * 1024 + col; st_bf16x8(d, v0, v1); };
            gemm_run<16>(ACT, 4096, W, 4096, 4096, shm, [&](int i, int& br, int& bc) { if (i >= 4) return false; const int it = blockIdx.x + (3 - i) * gridDim.x;     int pm, pn; tile_map(it, 256, 4, pm, pn); br = pm * 256; bc = pn * 256; return true; }, emit);
            for (int it = blockIdx.x; it < 8 * 16; it += gridDim.x) gemm_small<8>(ACT, 4096, W, 4096, 4096, NP + (it & 7) * 64, (it >> 3) * 64, (float*)smem, emit);
        } break;
        case 7: phase_rowpass(p, false, p.in[10], false); break;
        case 16: phase_rowpass(p, false, p.in[10] + 1024, true); break;
        case 8: {
            bf16_t* IN1 = R1;
            const bf16_t* W = (const bf16_t*)(ws + WS_W2T);
            auto emit = [&](int row, int col, f32x4 v0, f32x4 v1) { bf16_t* d = IN1 + (size_t)row * 1792 + col; st_bf16x8(d, v0, v1); };
            gemm_run<16>(H, 1024, W, 1024, 1024, shm, [&](int i, int& br, int& bc) { const int it = blockIdx.x + i * gridDim.x; if (it >= 256 * 7) return false; int pm, pn; tile_map(it, 256, 7, pm, pn); br = pm * 256; bc = pn * 256; return true; }, emit);
            for (int it = blockIdx.x; it < 8 * 28; it += gridDim.x) gemm_small<8>(H, 1024, W, 1024, 1024, NP + (it & 7) * 64, (it >> 3) * 64, (float*)smem, emit);
        } break;
        case 9: phase_l1rows(p); break;
        case 10: {
            const bf16_t* IN1 = R1;
            bf16_t* QF = R1 + R1_QF / 2; bf16_t* KVUP = R1 + R1_KVUP / 2; bf16_t* QLAT = R1 + R1_QLAT / 2;
            auto emit_kv = [&](int row, int col, f32x4 v0, f32x4 v1) { bf16_t* d = KVUP + (size_t)row * 1024 + col; st_bf16x8(d, v0, v1); };
            auto emit_qf = [&](int row, int col, f32x4 v0, f32x4 v1) { bf16_t* d = QF + (size_t)row * 768 + col; st_bf16x8(d, v0, v1); };
            auto emit_ql = [&](int row, int col, f32x4 v0, f32x4 v1) { bf16_t* d = QLAT + (size_t)(row - NP) * 2048 + col; st_bf16x8(d, v0, v1); };
            gemm_run<0>(IN1 + 1408, 1792, (const bf16_t*)(ws + WS_WKVT), 256, 256, shm, [&](int i, int& br, int& bc) { const int it = blockIdx.x + i * gridDim.x; if (it >= 256 * 4) return false; int pm, pn; tile_map(it, 256, 4, pm, pn); br = pm * 256; bc = pn * 256; return true; }, emit_kv);
            gemm_run<0>(IN1 + 1024, 1792, (const bf16_t*)(ws + WS_WUQT), 384, 384, shm, [&](int i, int& br, int& bc) { const int it = blockIdx.x + i * gridDim.x; if (it >= 256 * 3) return false; int pm, pn; tile_map(it, 256, 3, pm, pn); br = pm * 256; bc = pn * 256; return true; }, emit_qf);
            for (int it = blockIdx.x; it < 8 * 12 + 8 * 32; it += gridDim.x) {
                if (it < 96) gemm_small<4>(IN1 + 1024, 1792, (const bf16_t*)(ws + WS_WUQT), 384, 384, NP + (it & 7) * 64, (it >> 3) * 64, (float*)smem, emit_qf);
                else { const int i2 = it - 96; gemm_small<4>(IN1 + 1024, 1792, (const bf16_t*)(ws + WS_WQLT), 384, 384, NP + (i2 & 7) * 64, (i2 >> 3) * 64, (float*)smem, emit_ql); }
            }
        } break;
        case 11: {
            for (;;) {
                int it = next_item(ctr + 1 + 2 * rep, s_item_p);
                if (it >= 32 + 2048 + 2176) break;
                if (it < 32) attn_item<2>(p, it, smem);
                else {
                    const int i2 = it - 32;
                    if (i2 < 2 * 2048) { if (i2 & 1) sgu_item(p, i2 >> 1, smem); else attn_item<1>(p, i2 >> 1, smem); }
                    else sgu_item(p, i2 - 2048, smem);
                }
            }
        } break;
        default: break;
        }
    }
}

constexpr int NPHASE = 17;

extern "C" void kernel_launch(void* const* d_in, const int* in_sizes, int n_in, void* d_out, int out_size, void* d_ws, size_t ws_size, hipStream_t stream) {
    static int grid = 0;
    if (grid == 0) {
        int dev = 0, cus = 0, per_cu = 0;
        hipGetDevice(&dev);
        hipDeviceGetAttribute(&cus, hipDeviceAttributeMultiprocessorCount, dev);
        hipOccupancyMaxActiveBlocksPerMultiprocessor(&per_cu, mega, 512, 0);
        if (per_cu < 1) per_cu = 1;
        grid = cus * 1;
        if (ws_size < WS_END) { fprintf(stderr, "kernel_launch: workspace too small: %zu < %zu\n", ws_size, (size_t)WS_END); grid = -1; }
    }
    if (grid < 0) return;
    Params p{};
    for (int i = 0; i < 27; ++i) p.in[i] = (const float*)d_in[i];
    p.out = (float*)d_out; p.ws = (unsigned char*)d_ws;
    hipMemsetAsync(d_ws, 0, 16384, stream);
#ifdef MULTI_LAUNCH
    for (int ph = 0; ph < NPHASE; ++ph) hipLaunchKernelGGL(mega, dim3(grid), dim3(512), 0, stream, p, ph, ph + 1, 0);
#else
    int lo = 0, hi = NPHASE, coop = 1;
    void* args[] = {&p, &lo, &hi, &coop};
    hipError_t e = hipLaunchCooperativeKernel((void*)mega, dim3(grid), dim3(512), args, 0, stream);
    if (e != hipSuccess) fprintf(stderr, "cooperative launch failed: %s (grid %d)\n", hipGetErrorString(e), grid);
#endif
}
```

```cpp
#include <hip/hip_runtime.h>
#include <hip/hip_cooperative_groups.h>
#include <cstdio>
#include <cstdint>
namespace cg = cooperative_groups;

#define DEVI __device__ __forceinline__
typedef unsigned short bf16_t;
typedef short bf16x8 __attribute__((ext_vector_type(8)));
typedef short s4v __attribute__((ext_vector_type(4)));
typedef float f32x4 __attribute__((ext_vector_type(4)));
typedef float f32x16 __attribute__((ext_vector_type(16)));
typedef unsigned u32x4 __attribute__((ext_vector_type(4)));
typedef unsigned u32x2 __attribute__((ext_vector_type(2)));

constexpr int NP = 65536;
constexpr int NS = 512;
constexpr int MT = NP + NS;
constexpr float EPS = 1e-6f;
constexpr float LOG2E = 1.4426950408889634f;
constexpr float SBQ = 0.125f * LOG2E;
constexpr float MLQ = 0.10206207261596577f * LOG2E;

constexpr size_t O_Y = 0;
constexpr size_t O_SBK_P = (size_t)MT * 1024;
constexpr size_t O_SBV_P = O_SBK_P + (size_t)NP * 512;
constexpr size_t O_CONV_P = O_SBV_P + (size_t)NP * 512;
constexpr size_t O_CKV_P = O_CONV_P + 32 * 2 * 512;
constexpr size_t O_KPE_P = O_CKV_P + (size_t)NP * 256;
constexpr size_t O_SBK_S = O_KPE_P + (size_t)NP * 32;
constexpr size_t O_SBV_S = O_SBK_S + (size_t)NS * 512;
constexpr size_t O_CONV_S = O_SBV_S + (size_t)NS * 512;
constexpr size_t O_CKV_S = O_CONV_S + 32 * 2 * 512;
constexpr size_t O_KPE_S = O_CKV_S + (size_t)NS * 256;
constexpr size_t O_SGUV_S = O_KPE_S + (size_t)NS * 32;

constexpr size_t WS_CTR = 0;
constexpr size_t WS_W1T = 16384;
constexpr size_t WS_WO1T = WS_W1T + 3072ull * 1024 * 2;
constexpr size_t WS_WUP0 = WS_WO1T + 1024ull * 1024 * 2;
constexpr size_t WS_WDN0 = WS_WUP0 + 4096ull * 1024 * 2;
constexpr size_t WS_WUP1 = WS_WDN0 + 4096ull * 1024 * 2;
constexpr size_t WS_WDN1 = WS_WUP1 + 4096ull * 1024 * 2;
constexpr size_t WS_W2T = WS_WDN1 + 4096ull * 1024 * 2;
constexpr size_t WS_WUQT = WS_W2T + 1792ull * 1024 * 2;
constexpr size_t WS_WKVT = WS_WUQT + 768ull * 384 * 2;
constexpr size_t WS_WQLT = WS_WKVT + 1024ull * 256 * 2;
constexpr size_t WS_WO2T = WS_WQLT + 2048ull * 384 * 2;
constexpr size_t WS_H = WS_WO2T + 1024ull * 1024 * 2;
constexpr size_t WS_O = WS_H + (size_t)MT * 1024 * 2;
constexpr size_t WS_KC = WS_O + (size_t)MT * 1024 * 2;
constexpr size_t WS_R1 = WS_KC + 32ull * 4112 * 288 * 2;
constexpr size_t R1_QKVG = 0;
constexpr size_t R1_MIXED = (size_t)MT * 3072 * 2;
constexpr size_t R1_ACT = 0;
constexpr size_t R1_IN1 = 0;
constexpr size_t R1_QF = (size_t)MT * 1792 * 2;
constexpr size_t R1_KVUP = R1_QF + (size_t)MT * 768 * 2;
constexpr size_t R1_QLAT = R1_KVUP + (size_t)MT * 1024 * 2;
constexpr size_t R1_MIXED2 = R1_QLAT + 512ull * 2048 * 2;
constexpr size_t WS_RS = WS_R1 + R1_MIXED2 + (size_t)MT * 1024 * 2;
constexpr size_t WS_END = WS_RS + (size_t)MT * 4;

struct Params {
    const float* in[27];
    float* out;
    unsigned char* ws;
};

typedef __bf16 bf2v __attribute__((ext_vector_type(2)));
DEVI unsigned short f2bf(float f) { __bf16 v = (__bf16)f; return __builtin_bit_cast(unsigned short, v); }
DEVI unsigned pk2(float a, float b) { bf2v v = {(__bf16)a, (__bf16)b}; return __builtin_bit_cast(unsigned, v); }
DEVI float bflo(unsigned w) { return __uint_as_float(w << 16); }
DEVI float bfhi(unsigned w) { return __uint_as_float(w & 0xffff0000u); }
DEVI float bf2f(unsigned short h) { return __uint_as_float(((unsigned)h) << 16); }
DEVI float wave_sum(float v) {
#pragma unroll
    for (int o = 32; o > 0; o >>= 1) v += __shfl_xor(v, o);
    return v;
}
DEVI void unpack8(u32x4 w, float* f) {
    f[0] = bflo(w.x); f[1] = bfhi(w.x); f[2] = bflo(w.y); f[3] = bfhi(w.y);
    f[4] = bflo(w.z); f[5] = bfhi(w.z); f[6] = bflo(w.w); f[7] = bfhi(w.w);
}
DEVI u32x4 pack8(const float* f) { u32x4 w; w.x = pk2(f[0], f[1]); w.y = pk2(f[2], f[3]); w.z = pk2(f[4], f[5]); w.w = pk2(f[6], f[7]); return w; }
DEVI int get_tid() { int t = threadIdx.x; asm volatile("" : "+v"(t)); return t; }
DEVI int row_pos(int row) { return row < NP ? (row & 2047) : 4096 + ((row - NP) & 15); }

constexpr int BM = 256, BK = 64, HALF = 128, HT = HALF * BK;
DEVI int lds_byte(int r, int c) {
    int st = (r >> 4) * 2 + (c >> 5), rr = r & 15, cc = c & 31, ob = rr * 64 + cc * 2;
    return st * 1024 + (ob ^ (((ob >> 9) & 1) << 5));
}
DEVI void stage_rc(int b, int& R, int& C) {
    int st = b / 1024, sb = b % 1024, swz = sb ^ (((sb >> 9) & 1) << 5);
    R = (st >> 1) * 16 + swz / 64; C = (st & 1) * 32 + (swz % 64) / 2;
}

#define LAS __attribute__((address_space(3)))
template <int NSTORE, class TF, class F>
DEVI void gemm_run(const bf16_t* __restrict__ A, int lda, const bf16_t* __restrict__ Bt, int ldb, int K, bf16_t* shm, TF&& tile, F&& emit) {
    LAS unsigned char* lds = (LAS unsigned char*)shm;
    const int tid = get_tid(), wid = __builtin_amdgcn_readfirstlane(tid >> 6), lane = tid & 63, wr = wid >> 2, wc = wid & 3, fr = lane & 15, fq = lane >> 4;
    const int nt = K / BK;
    unsigned voffA[2], voffB[2];
#pragma unroll
    for (int i = 0; i < 2; ++i) { int R, C; stage_rc(tid * 16 + i * 8192, R, C); const int rho = R & 31; const int Rb = (R & ~31) + (8 * ((rho & 15) >> 2) + 4 * (rho >> 4) + (rho & 3));
        voffA[i] = (unsigned)(R * lda + C) * 2u; voffB[i] = (unsigned)(Rb * ldb + C) * 2u; }
    const size_t kstep = (size_t)(BK * 2);
    const size_t hstepA = (size_t)HALF * lda * 2, hstepB = (size_t)HALF * ldb * 2;
    const unsigned ldsw = (unsigned)wid * 1024u;
    const int aoff = lds_byte(wr * 64 + fr, fq * 8), boff = lds_byte(wc * 32 + fr, fq * 8);
    constexpr int HTB = HALF * BK * 2;
#define G_SA(b, h) (((b) * 2 + (h)) * HTB)
#define G_SB(b, h) ((4 + (b) * 2 + (h)) * HTB)
#define G_STAGE(bufoff, gbase, voff) do { _Pragma("unroll") for (int _i = 0; _i < 2; ++_i) \
        __builtin_amdgcn_global_load_lds((const unsigned*)((const char*)(gbase) + (voff)[_i]), (LAS unsigned*)(lds + (bufoff) + ldsw + _i * 8192), 16, 0, 0); } while (0)
#define G_LDA(dst, b, h) do { _Pragma("unroll") for (int m = 0; m < 4; ++m) _Pragma("unroll") for (int k = 0; k < 2; ++k) dst[m][k] = *(const LAS bf16x8*)(lds + G_SA(b, h) + aoff + m * 2048 + k * 1024); } while (0)
#define G_LDB(dst, b, h) do { _Pragma("unroll") for (int n = 0; n < 2; ++n) _Pragma("unroll") for (int k = 0; k < 2; ++k) dst[n][k] = *(const LAS bf16x8*)(lds + G_SB(b, h) + boff + n * 2048 + k * 1024); } while (0)
#define G_MMA(ai, bj, At, Bt_) do { __builtin_amdgcn_s_setprio(1); _Pragma("unroll") for (int m = 0; m < 4; ++m) _Pragma("unroll") for (int n = 0; n < 2; ++n) _Pragma("unroll") for (int k = 0; k < 2; ++k) \
        acc[ai][bj][m][n] = __builtin_amdgcn_mfma_f32_16x16x32_bf16(Bt_[n][k], At[m][k], acc[ai][bj][m][n], 0, 0, 0); __builtin_amdgcn_s_setprio(0); } while (0)
#define G_WAIT_V(n) asm volatile("s_waitcnt vmcnt(" #n ")" ::: "memory")
#define G_WAIT_L(n) asm volatile("s_waitcnt lgkmcnt(" #n ")" ::: "memory")
#define G_BAR __builtin_amdgcn_s_barrier()
#define G_SCHED __builtin_amdgcn_sched_barrier(0)
    int brow, bcol, nrow, ncol; int ui = 0;
    if (!tile(0, brow, bcol)) return;
    f32x4 acc[2][2][4][2];
#pragma unroll
    for (int a = 0; a < 2; ++a)
#pragma unroll
        for (int b = 0; b < 2; ++b)
#pragma unroll
            for (int m = 0; m < 4; ++m)
#pragma unroll
                for (int n = 0; n < 2; ++n) acc[a][b][m][n] = (f32x4){0.f, 0.f, 0.f, 0.f};
    bf16x8 At[4][2], B0[2][2], B1[2][2];
    const char* cA = (const char*)A + (size_t)brow * lda * 2; const char* cB = (const char*)Bt + (size_t)bcol * ldb * 2;
    G_STAGE(G_SB(0, 0), cB, voffB); G_STAGE(G_SB(0, 1), cB + hstepB, voffB); G_STAGE(G_SA(0, 0), cA, voffA); G_STAGE(G_SA(0, 1), cA + hstepA, voffA);
    if (wr == 1) G_BAR;
    G_WAIT_V(2); G_BAR;
    G_STAGE(G_SB(1, 0), cB + kstep, voffB); G_STAGE(G_SA(1, 0), cA + kstep, voffA); G_STAGE(G_SB(1, 1), cB + hstepB + kstep, voffB);
    G_WAIT_V(6); G_BAR;
    for (;;) {
        const bool has_next = tile(ui + 1, nrow, ncol);
        const char* nA = has_next ? (const char*)A + (size_t)nrow * lda * 2 : cA; const char* nB = has_next ? (const char*)Bt + (size_t)ncol * ldb * 2 : cB;
        for (int t = 0; t < nt; t += 2) {
            const bool last = (t == nt - 2);
            const char* a1 = cA + (size_t)(t + 1) * kstep;
            const char* a2 = last ? nA : cA + (size_t)(t + 2) * kstep; const char* b2 = last ? nB : cB + (size_t)(t + 2) * kstep;
            const char* a3 = a2 + kstep; const char* b3 = b2 + kstep;
            G_LDB(B0, 0, 0); G_LDB(B1, 0, 1); G_SCHED; G_LDA(At, 0, 0); G_STAGE(G_SA(1, 1), a1 + hstepA, voffA);
            G_WAIT_V(8); G_WAIT_L(0); G_BAR; G_MMA(0, 0, At, B0); G_MMA(0, 1, At, B1); G_BAR; G_SCHED;
            G_LDA(At, 0, 1); G_STAGE(G_SB(0, 0), b2, voffB); G_STAGE(G_SB(0, 1), b2 + hstepB, voffB); G_STAGE(G_SA(0, 0), a2, voffA);
            G_WAIT_V(8); G_WAIT_L(0); G_BAR; G_MMA(1, 0, At, B0); G_MMA(1, 1, At, B1); G_BAR; G_SCHED;
            G_LDB(B0, 1, 0); G_LDB(B1, 1, 1); G_SCHED; G_LDA(At, 1, 0); G_STAGE(G_SA(0, 1), a2 + hstepA, voffA);
            G_WAIT_V(8); G_WAIT_L(0); G_BAR; G_MMA(0, 0, At, B0); G_MMA(0, 1, At, B1); G_BAR; G_SCHED;
            G_LDA(At, 1, 1); G_STAGE(G_SB(1, 0), b3, voffB); G_STAGE(G_SB(1, 1), b3 + hstepB, voffB); G_STAGE(G_SA(1, 0), a3, voffA);
            G_WAIT_V(8); G_WAIT_L(0); G_BAR; G_MMA(1, 0, At, B0); G_MMA(1, 1, At, B1); G_BAR; G_SCHED;
        }
        if (NSTORE != 0 && wr == 0) G_BAR;
#pragma unroll
        for (int ai = 0; ai < 2; ++ai)
#pragma unroll
            for (int m = 0; m < 4; ++m)
#pragma unroll
                for (int bj = 0; bj < 2; ++bj)
                    emit(brow + ai * HALF + wr * 64 + m * 16 + fr, bcol + bj * HALF + wc * 32 + fq * 8, acc[ai][bj][m][0], acc[ai][bj][m][1]);
        if (!has_next) break;
#pragma unroll
        for (int a = 0; a < 2; ++a)
#pragma unroll
            for (int b = 0; b < 2; ++b)
#pragma unroll
                for (int m = 0; m < 4; ++m)
#pragma unroll
                    for (int n = 0; n < 2; ++n) acc[a][b][m][n] = (f32x4){0.f, 0.f, 0.f, 0.f};
        brow = nrow; bcol = ncol; cA = nA; cB = nB; ++ui;
        if (NSTORE != 0 && wr == 1) G_BAR;
    }
    G_WAIT_V(0);
    if (NSTORE == 0 && wr == 0) G_BAR;
    G_BAR;
#undef G_SA
#undef G_SB
#undef G_STAGE
#undef G_LDA
#undef G_LDB
#undef G_MMA
}

DEVI void tile_map(int L, int nM, int nN, int& pm, int& pn) {
    const int nwg = nM * nN;
    int wgid = L;
    { const int q = nwg / 8, r = nwg % 8, xcd = wgid % 8, off = wgid / 8; wgid = (xcd < r ? xcd * (q + 1) : r * (q + 1) + (xcd - r) * q) + off; }
    const int nig = 8 * nN, gid = wgid / nig, fm = gid * 8, gsz = (nM - fm) < 8 ? (nM - fm) : 8;
    pm = fm + ((wgid % nig) % gsz); pn = (wgid % nig) / gsz;
}

template <int KW, class F>
DEVI void gemm_small(const bf16_t* __restrict__ A, int lda, const bf16_t* __restrict__ Bt, int ldb, int K, int row0, int col0, float* lds, F&& emit) {
    constexpr int RW = 8 / KW, MT16 = 4 / RW;
    const int tid = get_tid(), wv = tid >> 6, lane = tid & 63, fr = lane & 15, fq = lane >> 4;
    const int kq = wv % KW, rh = wv / KW;
    const int ks = K / KW, kbeg = kq * ks;
    f32x4 acc[MT16][4];
#pragma unroll
    for (int m = 0; m < MT16; ++m)
#pragma unroll
        for (int n = 0; n < 4; ++n) acc[m][n] = (f32x4){0.f, 0.f, 0.f, 0.f};
    const bf16_t* ap = A + (size_t)(row0 + rh * (64 / RW) + fr) * lda + kbeg + 8 * fq;
    const bf16_t* bp = Bt + (size_t)(col0 + 8 * (fr >> 2) + (fr & 3)) * ldb + kbeg + 8 * fq;
#pragma unroll 4
    for (int k = 0; k < ks; k += 32) {
        bf16x8 af[MT16], bfr[4];
#pragma unroll
        for (int m = 0; m < MT16; ++m) af[m] = *(const bf16x8*)(ap + (size_t)(m * 16) * lda + k);
#pragma unroll
        for (int n = 0; n < 4; ++n) bfr[n] = *(const bf16x8*)(bp + (size_t)((n >> 1) * 32 + (n & 1) * 4) * ldb + k);
#pragma unroll
        for (int m = 0; m < MT16; ++m)
#pragma unroll
            for (int n = 0; n < 4; ++n) acc[m][n] = __builtin_amdgcn_mfma_f32_16x16x32_bf16(bfr[n], af[m], acc[m][n], 0, 0, 0);
    }
    __syncthreads();
    float* slab = lds + kq * 4096;
#pragma unroll
    for (int m = 0; m < MT16; ++m)
#pragma unroll
        for (int n = 0; n < 4; ++n) {
            const int row = rh * (64 / RW) + m * 16 + fr, grp = ((n >> 1) * 8 + 2 * fq + (n & 1)) ^ (row & 15);
            *(f32x4*)(slab + row * 64 + grp * 4) = acc[m][n];
        }
    __syncthreads();
    {
        const int row = tid >> 3, c = tid & 7, g0 = c * 2, g1 = g0 + 1;
        f32x4 v0 = {0.f, 0.f, 0.f, 0.f}, v1 = {0.f, 0.f, 0.f, 0.f};
#pragma unroll
        for (int w = 0; w < KW; ++w) {
            v0 += *(const f32x4*)(lds + w * 4096 + row * 64 + ((g0 ^ (row & 15)) * 4));
            v1 += *(const f32x4*)(lds + w * 4096 + row * 64 + ((g1 ^ (row & 15)) * 4));
        }
        emit(row0 + row, col0 + g0 * 4, v0, v1);
    }
    __syncthreads();
}

DEVI void st_bf16x8(bf16_t* p, f32x4 a, f32x4 b) { u32x4 w; w.x = pk2(a[0], a[1]); w.y = pk2(a[2], a[3]); w.z = pk2(b[0], b[1]); w.w = pk2(b[2], b[3]); *(u32x4*)p = w; }

struct TJob { const float* src; bf16_t* dst; int K, N, Npad, src_ld; float scale; int scale_cols; const float* kgain; };
DEVI bool get_tjob(const Params& p, int j, TJob& t) {
    unsigned char* ws = p.ws;
    switch (j) {
    case 0: t = {p.in[11], (bf16_t*)(ws + WS_W1T), 1024, 3072, 3072, 3072, SBQ, 512, p.in[7]}; return true;
    case 1: t = {p.in[13], (bf16_t*)(ws + WS_WO1T), 1024, 1024, 1024, 1024, 1.f, 0, nullptr}; return true;
    case 2: t = {p.in[25], (bf16_t*)(ws + WS_WUP0), 1024, 4096, 4096, 4096, 1.f, 0, p.in[9]}; return true;
    case 3: t = {p.in[25] + 1024ull * 4096, (bf16_t*)(ws + WS_WUP1), 1024, 4096, 4096, 4096, 1.f, 0, p.in[9] + 1024}; return true;
    case 4: t = {p.in[26], (bf16_t*)(ws + WS_WDN0), 4096, 1024, 1024, 1024, 1.f, 0, nullptr}; return true;
    case 5: t = {p.in[26] + 1024ull * 4096, (bf16_t*)(ws + WS_WDN1), 4096, 1024, 1024, 1024, 1.f, 0, nullptr}; return true;
    case 6: t = {p.in[14], (bf16_t*)(ws + WS_W2T), 1024, 1696, 1792, 1696, 1.f, 0, p.in[7] + 1024}; return true;
    case 7: t = {p.in[21], (bf16_t*)(ws + WS_WUQT), 384, 768, 768, 768, MLQ, 768, nullptr}; return true;
    case 8: t = {p.in[24], (bf16_t*)(ws + WS_WO2T), 1024, 1024, 1024, 1024, 1.f, 0, nullptr}; return true;
    default:
        if (j < 17) { int h = j - 9; t = {p.in[23] + (size_t)h * 256 * 64, (bf16_t*)(ws + WS_WKVT) + (size_t)(512 + h * 64) * 256, 256, 64, 64, 64, 1.f, 0, nullptr}; return true; }
        return false;
    }
}

DEVI void phase_prep(const Params& p, float* lds) {
    const int tid = get_tid();
    int base = 0;
    for (int j = 0; j < 17; ++j) {
        TJob t; get_tjob(p, j, t);
        const int tk = t.K / 64, tn = t.Npad / 64, ntile = tk * tn;
        int first = ((int)blockIdx.x - base % (int)gridDim.x + (int)gridDim.x) % (int)gridDim.x;
        for (int i = first; i < ntile; i += gridDim.x) {
            const int k0 = (i % tk) * 64, n0 = (i / tk) * 64;
            __syncthreads();
#pragma unroll
            for (int e = 0; e < 2; ++e) {
                const int idx = tid + e * 512, kk = idx >> 4, n4 = (idx & 15) * 4, n = n0 + n4;
                f32x4 v = {0.f, 0.f, 0.f, 0.f};
                if (n < t.N) { v = *(const f32x4*)(t.src + (size_t)(k0 + kk) * t.src_ld + n); if (n < t.scale_cols) v = v * t.scale; if (t.kgain) v = v * t.kgain[k0 + kk]; }
                lds[kk * 65 + n4] = v[0]; lds[kk * 65 + n4 + 1] = v[1]; lds[kk * 65 + n4 + 2] = v[2]; lds[kk * 65 + n4 + 3] = v[3];
            }
            __syncthreads();
            {
                const int nn = tid >> 3, kc = tid & 7;
                float o[8];
#pragma unroll
                for (int j = 0; j < 8; ++j) o[j] = lds[(kc * 8 + j) * 65 + nn];
                *(u32x4*)(t.dst + (size_t)(n0 + nn) * t.K + k0 + kc * 8) = pack8(o);
            }
        }
        base += ntile;
    }
    const int gtid = blockIdx.x * 512 + tid, gsz = gridDim.x * 512;
    {
        bf16_t* dst = (bf16_t*)(p.ws + WS_WKVT);
        const float* src = p.in[22];
        for (int i = gtid; i < 512 * 256; i += gsz) dst[i] = f2bf(src[i]);
    }
    {
        bf16_t* dst = (bf16_t*)(p.ws + WS_WQLT);
        const float* wuq = p.in[21];
        const float* wuk = p.in[22];
        for (int i = gtid; i < 2048 * 384; i += gsz) {
            int c = i & 255, h = (i >> 8) & 7, j = i >> 11;
            const float* a = wuq + (size_t)j * 768 + h * 96;
            const float* b = wuk + (size_t)h * 64 * 256 + c;
            float s = 0.f;
#pragma unroll 8
            for (int n = 0; n < 64; ++n) s += a[n] * b[(size_t)n * 256];
            dst[(size_t)(h * 256 + c) * 384 + j] = f2bf(s * MLQ);
        }
    }
    {
        const int wv = tid >> 6, lane = tid & 63;
        bf16_t* X = (bf16_t*)(p.ws + WS_H);
        float* RS = (float*)(p.ws + WS_RS);
        for (int rowb = (blockIdx.x * 8 + wv) * 2; rowb < MT; rowb += gridDim.x * 16) {
            float v[2][16]; float ss[2] = {0.f, 0.f};
#pragma unroll
            for (int rr = 0; rr < 2; ++rr) {
                const int row = rowb + rr;
                const float* x = row < NP ? p.in[0] + (size_t)row * 1024 : p.in[1] + (size_t)(row - NP) * 1024;
#pragma unroll
                for (int i = 0; i < 2; ++i) {
                    f32x4 a = *(const f32x4*)(x + i * 512 + lane * 8), b = *(const f32x4*)(x + i * 512 + lane * 8 + 4);
#pragma unroll
                    for (int k = 0; k < 4; ++k) { v[rr][i * 8 + k] = a[k]; v[rr][i * 8 + 4 + k] = b[k]; }
                }
            }
#pragma unroll
            for (int rr = 0; rr < 2; ++rr)
#pragma unroll
                for (int k = 0; k < 16; ++k) ss[rr] += v[rr][k] * v[rr][k];
#pragma unroll
            for (int of = 32; of > 0; of >>= 1) { ss[0] += __shfl_xor(ss[0], of); ss[1] += __shfl_xor(ss[1], of); }
#pragma unroll
            for (int rr = 0; rr < 2; ++rr) {
                const float r = rsqrtf(ss[rr] * (1.f / 1024.f) + EPS);
#pragma unroll
                for (int k = 0; k < 16; ++k) v[rr][k] *= r;
#pragma unroll
                for (int i = 0; i < 2; ++i) *(u32x4*)(X + (size_t)(rowb + rr) * 1024 + i * 512 + lane * 8) = pack8(v[rr] + i * 8);
                if (lane == 0) RS[rowb + rr] = r;
            }
        }
    }
}

DEVI void phase_rowpass(const Params& p, bool first, const float* g1, bool final_) {
    const int tid = get_tid(), wv = tid >> 6, lane = tid & 63;
    const bf16_t* O = (const bf16_t*)(p.ws + WS_O);
    bf16_t* X = (bf16_t*)(p.ws + WS_H);
    float* RS = (float*)(p.ws + WS_RS);
    float ga[16];
#pragma unroll
    for (int i = 0; i < 2; ++i)
#pragma unroll
        for (int k = 0; k < 8; ++k) ga[i * 8 + k] = g1[i * 512 + lane * 8 + k];
    for (int rowb = (blockIdx.x * 8 + wv) * 2; rowb < MT; rowb += gridDim.x * 16) {
        float o[2][16], x[2][16];
#pragma unroll
        for (int rr = 0; rr < 2; ++rr) {
            const int row = rowb + rr;
#pragma unroll
            for (int i = 0; i < 2; ++i) {
                unpack8(*(const u32x4*)(O + (size_t)row * 1024 + i * 512 + lane * 8), o[rr] + i * 8);
                if (first) {
                    const float* xin = row < NP ? p.in[0] + (size_t)row * 1024 : p.in[1] + (size_t)(row - NP) * 1024;
                    f32x4 a = *(const f32x4*)(xin + i * 512 + lane * 8), b = *(const f32x4*)(xin + i * 512 + lane * 8 + 4);
#pragma unroll
                    for (int k = 0; k < 4; ++k) { x[rr][i * 8 + k] = a[k]; x[rr][i * 8 + 4 + k] = b[k]; }
                } else unpack8(*(const u32x4*)(X + (size_t)row * 1024 + i * 512 + lane * 8), x[rr] + i * 8);
            }
            if (!first) {
                const float inv = 1.f / RS[row];
#pragma unroll
                for (int k = 0; k < 16; ++k) x[rr][k] *= inv;
            }
        }
        float ss[2] = {0.f, 0.f};
#pragma unroll
        for (int rr = 0; rr < 2; ++rr)
#pragma unroll
            for (int k = 0; k < 16; ++k) ss[rr] += o[rr][k] * o[rr][k];
#pragma unroll
        for (int of = 32; of > 0; of >>= 1) { ss[0] += __shfl_xor(ss[0], of); ss[1] += __shfl_xor(ss[1], of); }
        float s2[2] = {0.f, 0.f};
#pragma unroll
        for (int rr = 0; rr < 2; ++rr) {
            const float r = rsqrtf(ss[rr] * (1.f / 1024.f) + EPS);
#pragma unroll
            for (int k = 0; k < 16; ++k) { float v = x[rr][k] + o[rr][k] * r * ga[k]; x[rr][k] = v; s2[rr] += v * v; }
        }
        if (final_) {
#pragma unroll
            for (int rr = 0; rr < 2; ++rr) {
                float* y = p.out + O_Y + (size_t)(rowb + rr) * 1024;
#pragma unroll
                for (int i = 0; i < 2; ++i) {
                    *(f32x4*)(y + i * 512 + lane * 8) = (f32x4){x[rr][i * 8], x[rr][i * 8 + 1], x[rr][i * 8 + 2], x[rr][i * 8 + 3]};
                    *(f32x4*)(y + i * 512 + lane * 8 + 4) = (f32x4){x[rr][i * 8 + 4], x[rr][i * 8 + 5], x[rr][i * 8 + 6], x[rr][i * 8 + 7]};
                }
            }
        } else {
#pragma unroll
            for (int of = 32; of > 0; of >>= 1) { s2[0] += __shfl_xor(s2[0], of); s2[1] += __shfl_xor(s2[1], of); }
#pragma unroll
            for (int rr = 0; rr < 2; ++rr) {
                const float r2 = rsqrtf(s2[rr] * (1.f / 1024.f) + EPS);
#pragma unroll
                for (int k = 0; k < 16; ++k) x[rr][k] *= r2;
#pragma unroll
                for (int i = 0; i < 2; ++i) *(u32x4*)(X + (size_t)(rowb + rr) * 1024 + i * 512 + lane * 8) = pack8(x[rr] + i * 8);
                if (lane == 0) RS[rowb + rr] = r2;
            }
        }
    }
}

DEVI void rope_consts(int i, float& crev) { crev = __builtin_amdgcn_exp2f(-(float)i * (13.287712379549449f / 16.f)) * 0.15915494309189535f; }
DEVI void rope_sc(int pos, float crev, float& s, float& c) { float rev = (float)pos * crev; rev -= floorf(rev); s = __builtin_amdgcn_sinf(rev); c = __builtin_amdgcn_cosf(rev); }

DEVI void phase_l1rows(const Params& p) {
    const int tid = get_tid(), wv = tid >> 6, lane = tid & 63;
    bf16_t* IN1 = (bf16_t*)(p.ws + WS_R1 + R1_IN1);
    bf16_t* KC = (bf16_t*)(p.ws + WS_KC);
    const float* lng = p.in[15]; const float* lnb = p.in[16]; const float* qg = p.in[19]; const float* kvg = p.in[20];
    float crev; rope_consts(lane & 15, crev);
    float glng[8], glnb[8], gq[8], gkv[8];
#pragma unroll
    for (int k = 0; k < 8; ++k) { glng[k] = lng[lane * 8 + k]; glnb[k] = lnb[lane * 8 + k]; gq[k] = lane < 48 ? qg[lane * 8 + k] : 0.f; gkv[k] = lane < 32 ? kvg[lane * 8 + k] : 0.f; }
    for (int rowb = (blockIdx.x * 8 + wv) * 2; rowb < MT; rowb += gridDim.x * 16) {
        float v[2][8], cq[2][8], kv[2][8], x1[2], x2[2];
#pragma unroll
        for (int rr = 0; rr < 2; ++rr) {
            const bf16_t* r = IN1 + (size_t)(rowb + rr) * 1792;
            unpack8(*(const u32x4*)(r + 512 + lane * 8), v[rr]);
            u32x4 z = {0u, 0u, 0u, 0u};
            unpack8(lane < 48 ? *(const u32x4*)(r + 1024 + lane * 8) : z, cq[rr]);
            unpack8(lane < 32 ? *(const u32x4*)(r + 1408 + lane * 8) : z, kv[rr]);
            x1[rr] = lane < 16 ? bf2f(r[1664 + lane]) : 0.f; x2[rr] = lane < 16 ? bf2f(r[1680 + lane]) : 0.f;
        }
        float sv[2], sq[2], sk[2];
#pragma unroll
        for (int rr = 0; rr < 2; ++rr) {
            sv[rr] = 0.f; sq[rr] = 0.f; sk[rr] = 0.f;
#pragma unroll
            for (int k = 0; k < 8; ++k) { sv[rr] += v[rr][k]; sq[rr] += cq[rr][k] * cq[rr][k]; sk[rr] += kv[rr][k] * kv[rr][k]; }
        }
#pragma unroll
        for (int of = 32; of > 0; of >>= 1)
#pragma unroll
            for (int rr = 0; rr < 2; ++rr) { sv[rr] += __shfl_xor(sv[rr], of); sq[rr] += __shfl_xor(sq[rr], of); sk[rr] += __shfl_xor(sk[rr], of); }
        float var[2];
#pragma unroll
        for (int rr = 0; rr < 2; ++rr) {
            const float mu = sv[rr] * (1.f / 512.f); var[rr] = 0.f;
#pragma unroll
            for (int k = 0; k < 8; ++k) { v[rr][k] -= mu; var[rr] += v[rr][k] * v[rr][k]; }
        }
#pragma unroll
        for (int of = 32; of > 0; of >>= 1) { var[0] += __shfl_xor(var[0], of); var[1] += __shfl_xor(var[1], of); }
#pragma unroll
        for (int rr = 0; rr < 2; ++rr) {
            const int row = rowb + rr;
            bf16_t* r = IN1 + (size_t)row * 1792;
            {
                const float rs = rsqrtf(var[rr] * (1.f / 512.f) + EPS);
#pragma unroll
                for (int k = 0; k < 8; ++k) v[rr][k] = v[rr][k] * rs * glng[k] + glnb[k];
                *(u32x4*)(r + 512 + lane * 8) = pack8(v[rr]);
                if (row >= NP) {
                    float* o = p.out + O_SGUV_S + (size_t)(row - NP) * 512 + lane * 8;
                    *(f32x4*)o = (f32x4){v[rr][0], v[rr][1], v[rr][2], v[rr][3]}; *(f32x4*)(o + 4) = (f32x4){v[rr][4], v[rr][5], v[rr][6], v[rr][7]};
                }
            }
            if (lane < 48) {
                const float rs = rsqrtf(sq[rr] * (1.f / 384.f) + EPS);
#pragma unroll
                for (int k = 0; k < 8; ++k) cq[rr][k] = cq[rr][k] * rs * gq[k];
                *(u32x4*)(r + 1024 + lane * 8) = pack8(cq[rr]);
            }
            if (lane < 32) {
                const float rs = rsqrtf(sk[rr] * (1.f / 256.f) + EPS);
#pragma unroll
                for (int k = 0; k < 8; ++k) kv[rr][k] = kv[rr][k] * rs * gkv[k];
                u32x4 w = pack8(kv[rr]);
                *(u32x4*)(r + 1408 + lane * 8) = w;
                float* o = row < NP ? p.out + O_CKV_P + (size_t)row * 256 + lane * 8 : p.out + O_CKV_S + (size_t)(row - NP) * 256 + lane * 8;
                *(f32x4*)o = (f32x4){kv[rr][0], kv[rr][1], kv[rr][2], kv[rr][3]}; *(f32x4*)(o + 4) = (f32x4){kv[rr][4], kv[rr][5], kv[rr][6], kv[rr][7]};
                if (row >= NP) { int b = (row - NP) >> 4, t = (row - NP) & 15; *(u32x4*)(KC + ((size_t)b * 4112 + 4096 + t) * 288 + lane * 8) = w; }
            }
            if (lane < 16) {
                float sn, c; rope_sc(row_pos(row), crev, sn, c);
                float o1 = x1[rr] * c - x2[rr] * sn, o2 = x1[rr] * sn + x2[rr] * c;
                bf16_t b1 = f2bf(o1), b2 = f2bf(o2);
                r[1664 + lane] = b1; r[1680 + lane] = b2;
                float* o = row < NP ? p.out + O_KPE_P + (size_t)row * 32 : p.out + O_KPE_S + (size_t)(row - NP) * 32;
                o[lane] = o1; o[lane + 16] = o2;
                if (row >= NP) { int b = (row - NP) >> 4, t = (row - NP) & 15; bf16_t* kc = KC + ((size_t)b * 4112 + 4096 + t) * 288 + 256; kc[lane] = b1; kc[lane + 16] = b2; }
            }
        }
    }
}

DEVI void kc_item(const Params& p, int item) {
    const int tid = get_tid();
    bf16_t* KC = (bf16_t*)(p.ws + WS_KC);
    const float* cc = p.in[5]; const float* cp = p.in[6];
#pragma unroll
    for (int e = 0; e < 8; ++e) {
        const long id = (long)item * 4096 + e * 512 + tid;
        const long rw = id / 36; const int ch = (int)(id - rw * 36);
        const int b = (int)(rw >> 12), kk = (int)(rw & 4095);
        const float* src = ch < 32 ? cc + (size_t)rw * 256 + ch * 8 : cp + (size_t)rw * 32 + (ch - 32) * 8;
        f32x4 a = *(const f32x4*)src, bb = *(const f32x4*)(src + 4);
        u32x4 w; w.x = pk2(a[0], a[1]); w.y = pk2(a[2], a[3]); w.z = pk2(bb[0], bb[1]); w.w = pk2(bb[2], bb[3]);
        *(u32x4*)(KC + ((size_t)b * 4112 + kk) * 288 + ch * 8) = w;
    }
}

DEVI void conv_item(const Params& p, int item) {
    const int tid = get_tid(), ch = tid & 63, rs = tid >> 6;
    const bf16_t* Q = (const bf16_t*)(p.ws + WS_R1 + R1_QKVG);
    bf16_t* MX = (bf16_t*)(p.ws + WS_R1 + R1_MIXED);
    const float* wc = p.in[12];
    float w0[8], w1[8], w2[8];
#pragma unroll
    for (int k = 0; k < 8; ++k) { w0[k] = wc[ch * 8 + k]; w1[k] = wc[512 + ch * 8 + k]; w2[k] = wc[1024 + ch * 8 + k]; }
#pragma unroll 1
    for (int i = 0; i < 4; ++i) {
        int rbase = item * 32;
        if (item < 2048) { const int bi = item >> 6; rbase = ((bi & 7) * 4 + (3 - (bi >> 3))) * 2048 + (item & 63) * 32; }
        const int row = rbase + rs + i * 8;
        const bool samp = row >= NP;
        const int t = samp ? (row - NP) & 15 : row & 2047;
        const int b = samp ? (row - NP) >> 4 : row >> 11;
        float cin[3][8];
#pragma unroll
        for (int j = 0; j < 3; ++j) {
            if (t - j >= 0) {
                const bf16_t* rr = Q + (size_t)(row - j) * 3072;
                float a[8], u[8]; unpack8(*(const u32x4*)(rr + 2048 + ch * 8), a); unpack8(*(const u32x4*)(rr + 2560 + ch * 8), u);
#pragma unroll
                for (int k = 0; k < 8; ++k) cin[j][k] = a[k] * u[k];
            } else if (samp) {
                const float* pv = p.in[4] + ((size_t)b * 2 + (2 + t - j)) * 512 + ch * 8;
#pragma unroll
                for (int k = 0; k < 8; ++k) cin[j][k] = pv[k];
            } else {
#pragma unroll
                for (int k = 0; k < 8; ++k) cin[j][k] = 0.f;
            }
        }
        {
            float kf[8], vf[8];
            unpack8(*(const u32x4*)(Q + (size_t)row * 3072 + 512 + ch * 8), kf); unpack8(*(const u32x4*)(Q + (size_t)row * 3072 + 1024 + ch * 8), vf);
            float* ok = p.out + (samp ? O_SBK_S + (size_t)(row - NP) * 512 : O_SBK_P + (size_t)row * 512) + ch * 8;
            float* ov = p.out + (samp ? O_SBV_S + (size_t)(row - NP) * 512 : O_SBV_P + (size_t)row * 512) + ch * 8;
            *(f32x4*)ok = (f32x4){kf[0], kf[1], kf[2], kf[3]}; *(f32x4*)(ok + 4) = (f32x4){kf[4], kf[5], kf[6], kf[7]};
            *(f32x4*)ov = (f32x4){vf[0], vf[1], vf[2], vf[3]}; *(f32x4*)(ov + 4) = (f32x4){vf[4], vf[5], vf[6], vf[7]};
        }
        float gp[8]; unpack8(*(const u32x4*)(Q + (size_t)row * 3072 + 1536 + ch * 8), gp);
        float o[8];
#pragma unroll
        for (int k = 0; k < 8; ++k) o[k] = gp[k] * (w0[k] * cin[2][k] + w1[k] * cin[1][k] + w2[k] * cin[0][k]);
        *(u32x4*)(MX + (size_t)row * 1024 + 512 + ch * 8) = pack8(o);
        const int tl = samp ? 14 : 2046;
        if (t >= tl) {
            float* o2 = p.out + (samp ? O_CONV_S : O_CONV_P) + ((size_t)b * 2 + (t - tl)) * 512 + ch * 8;
#pragma unroll
            for (int k = 0; k < 8; ++k) o2[k] = cin[0][k];
        }
    }
}

DEVI s4v tr_read(const unsigned char* lp) { return __builtin_amdgcn_ds_read_tr16_b64_v4i16((__attribute__((address_space(3))) s4v*)(lp)); }

DEVI void sgu_item(const Params& p, int sg, unsigned char* smem) {
    const int tid = get_tid(), wv = tid >> 6, lane = tid & 63;
    int g, row0, L;
    if (sg < 2048) { const int chunk = sg >> 2; g = sg & 3; row0 = (chunk >> 4) * 2048 + (chunk & 15) * 128; L = 128; }
    else { const int s2 = sg - 2048; g = s2 & 3; row0 = NP + (s2 >> 2) * 16; L = 16; }
    bf16_t* IN1 = (bf16_t*)(p.ws + WS_R1 + R1_IN1);
    bf16_t* MX = (bf16_t*)(p.ws + WS_R1 + R1_MIXED2);
    const float* Wg = p.in[17] + (size_t)g * 128 * 128;
    const float* bs = p.in[18] + g * 128;
    constexpr int STR = 272;
    unsigned char* Wl = smem; unsigned char* Vl = smem + 128 * STR;
#pragma unroll
    for (int e = 0; e < 8; ++e) {
        int idx = tid + e * 512, t = idx >> 5, s4 = (idx & 31) * 4;
        f32x4 w = {0.f, 0.f, 0.f, 0.f};
        if (t < L) w = *(const f32x4*)(Wg + t * 128 + s4);
        float o[4];
#pragma unroll
        for (int k = 0; k < 4; ++k) o[k] = (s4 + k <= t && s4 + k < L) ? w[k] : 0.f;
        u32x2 pw; pw.x = pk2(o[0], o[1]); pw.y = pk2(o[2], o[3]);
        *(u32x2*)(Wl + t * STR + s4 * 2) = pw;
    }
#pragma unroll
    for (int e = 0; e < 4; ++e) {
        int idx = tid + e * 512, s = idx >> 4, c = idx & 15;
        u32x4 w = {0u, 0u, 0u, 0u};
        if (s < L) w = *(const u32x4*)(IN1 + (size_t)(row0 + s) * 1792 + 512 + g * 128 + c * 8);
        *(u32x4*)(Vl + s * STR + c * 16) = w;
    }
    __syncthreads();
    const int tb = wv >> 1, r = lane & 31, h = lane >> 5, grp = lane >> 4, q = (lane & 15) >> 2, pp = lane & 3;
    f32x16 acc[2] = {};
    if (tb * 32 < L) {
        for (int sb = 0; sb <= tb; ++sb) {
#pragma unroll
            for (int st = 0; st < 2; ++st) {
                bf16x8 a = *(const bf16x8*)(Wl + (tb * 32 + r) * STR + (sb * 32 + st * 16 + 8 * h) * 2);
#pragma unroll
                for (int d2 = 0; d2 < 2; ++d2) {
                    const int db = (wv & 1) * 2 + d2;
                    const unsigned char* vp = Vl + (sb * 32 + st * 16 + 8 * h + q) * STR + (db * 32 + 16 * (grp & 1) + 4 * pp) * 2;
                    s4v lo = tr_read(vp), hi = tr_read(vp + 4 * STR);
                    bf16x8 bfr = __builtin_shufflevector(lo, hi, 0, 1, 2, 3, 4, 5, 6, 7);
                    acc[d2] = __builtin_amdgcn_mfma_f32_32x32x16_bf16(a, bfr, acc[d2], 0, 0, 0);
                }
            }
        }
    }
    __syncthreads();
    float* Sl = (float*)smem;
    if (tb * 32 < L) {
#pragma unroll
        for (int d2 = 0; d2 < 2; ++d2) {
            const int d = ((wv & 1) * 2 + d2) * 32 + r;
#pragma unroll
            for (int reg = 0; reg < 16; ++reg) {
                const int t = tb * 32 + (reg & 3) + 8 * (reg >> 2) + 4 * h;
                Sl[t * 132 + d] = acc[d2][reg];
            }
        }
    }
    __syncthreads();
#pragma unroll
    for (int e = 0; e < 4; ++e) {
        const int idx = tid + e * 512, t = idx >> 4, c = idx & 15;
        if (t < L) {
            float u[8]; unpack8(*(const u32x4*)(IN1 + (size_t)(row0 + t) * 1792 + g * 128 + c * 8), u);
            const f32x4 s0 = *(const f32x4*)(Sl + t * 132 + c * 8), s1 = *(const f32x4*)(Sl + t * 132 + c * 8 + 4);
            const float bt = bs[t];
            float o[8];
#pragma unroll
            for (int k = 0; k < 4; ++k) { o[k] = u[k] * (s0[k] + bt); o[4 + k] = u[4 + k] * (s1[k] + bt); }
            *(u32x4*)(MX + (size_t)(row0 + t) * 1024 + g * 128 + c * 8) = pack8(o);
        }
    }
}

template <int MODE> struct AC;
template <> struct AC<0> { static constexpr int DQK = 64, DV = 64, KSTR = 144, VSTR = 144, NST = 2; };
template <> struct AC<1> { static constexpr int DQK = 96, DV = 64, KSTR = 208, VSTR = 192, NST = 3; };
template <> struct AC<2> { static constexpr int DQK = 288, DV = 256, KSTR = 592, VSTR = 592, NST = 5; };
constexpr int SM_V = 40960, SM_FLAG = 65536;

DEVI u32x4 ld_f32x8_bf16(const float* src) {
    f32x4 a = *(const f32x4*)src, b = *(const f32x4*)(src + 4);
    u32x4 w; w.x = pk2(a[0], a[1]); w.y = pk2(a[2], a[3]); w.z = pk2(b[0], b[1]); w.w = pk2(b[2], b[3]); return w;
}

template <int MODE>
DEVI void attn_item(const Params& p, int item, unsigned char* smem) {
    typedef AC<MODE> C;
    constexpr int KS = C::DQK / 16, DB = (MODE == 2) ? 4 : C::DV / 32, NST = C::NST, NQF = (MODE == 2) ? 1 : KS;
    const int tid = get_tid(), wv = tid >> 6, lane = tid & 63;
    const int r = lane & 31, h = lane >> 5, grp = lane >> 4, q4 = (lane & 15) >> 2, pp = lane & 3;
    unsigned char* Ks = smem;
    unsigned char* Vs = (MODE == 2) ? smem : smem + SM_V;
    unsigned char* Qs = smem + SM_V;
    volatile int* flags = (volatile int*)(smem + SM_FLAG);

    int b = 0, hd = 0, q0 = 0, kt_last = 0; bool samp = false;
    if constexpr (MODE == 0) {
        if (item < 2048) { const int bi = item >> 6, qb = 7 - ((item >> 3) & 7); b = (bi & 7) * 4 + (3 - (bi >> 3)); hd = item & 7; q0 = qb * 256; kt_last = (q0 + 255) >> 6; }
        else { const int s = item - 2048; b = s >> 3; hd = s & 7; samp = true; q0 = 4096; kt_last = 64; }
    } else if constexpr (MODE == 1) {
        const int qb = 7 - (item >> 8); b = (item & 255) >> 3; hd = item & 7; q0 = qb * 256; kt_last = (q0 + 255) >> 6;
    } else { b = item; kt_last = 64; }
    const bf16_t* QKVG = (const bf16_t*)(p.ws + WS_R1 + R1_QKVG);
    const bf16_t* IN1 = (const bf16_t*)(p.ws + WS_R1 + R1_IN1);
    const bf16_t* QF = (const bf16_t*)(p.ws + WS_R1 + R1_QF);
    const bf16_t* KVUP = (const bf16_t*)(p.ws + WS_R1 + R1_KVUP);
    const bf16_t* QLAT = (const bf16_t*)(p.ws + WS_R1 + R1_QLAT);
    const bf16_t* KC = (const bf16_t*)(p.ws + WS_KC);

    bool wactive; int qpos = 0; bool qvalid = true; size_t orow = 0;
    bf16x8 qf[NQF];
    const int rg = wv & 3, dvh = (MODE == 2) ? (wv >> 2) : 0;
    if constexpr (MODE == 0) {
        wactive = samp ? (wv == 0) : true;
        int qi = samp ? (r & 15) : (wv * 32 + r);
        qvalid = samp ? (r < 16) : true;
        qpos = q0 + qi;
        orow = samp ? (size_t)(NP + b * 16 + qi) : (size_t)(b * 2048 + q0 + qi);
        const bf16_t* qp = QKVG + orow * 3072 + hd * 64;
#pragma unroll
        for (int st = 0; st < KS; ++st) qf[st] = *(const bf16x8*)(qp + st * 16 + 8 * h);
    } else if constexpr (MODE == 1) {
        wactive = true; qpos = q0 + wv * 32 + r; orow = (size_t)(b * 2048 + qpos);
        const bf16_t* qp = QF + orow * 768 + hd * 96;
#pragma unroll
        for (int st = 0; st < KS; ++st) qf[st] = *(const bf16x8*)(qp + st * 16 + 8 * h);
#pragma unroll
        for (int j = 0; j < 8; ++j) {
            float crev; rope_consts(8 * h + j, crev);
            float sn, cs; rope_sc(qpos, crev, sn, cs);
            const float x1 = bf2f((unsigned short)qf[4][j]), x2 = bf2f((unsigned short)qf[5][j]);
            qf[4][j] = (short)f2bf(x1 * cs - x2 * sn); qf[5][j] = (short)f2bf(x1 * sn + x2 * cs);
        }
    } else {
        wactive = true;
        for (int id = tid; id < 128 * 36; id += 512) {
            const int rr = id / 36, ch = id % 36, hh = rr >> 4, t = rr & 15;
            u32x4 w = ch < 32 ? *(const u32x4*)(QLAT + (size_t)(b * 16 + t) * 2048 + hh * 256 + ch * 8)
                              : *(const u32x4*)(QF + (size_t)(NP + b * 16 + t) * 768 + hh * 96 + 64 + (ch - 32) * 8);
            *(u32x4*)(Qs + rr * 592 + ch * 16) = w;
        }
        __syncthreads();
        for (int id = tid; id < 128 * 16; id += 512) {
            const int rr = id >> 4, i = id & 15, t = rr & 15;
            bf16_t* qrow = (bf16_t*)(Qs + rr * 592);
            float crev; rope_consts(i, crev);
            float sn, cs; rope_sc(4096 + t, crev, sn, cs);
            const float x1 = bf2f(qrow[256 + i]), x2 = bf2f(qrow[272 + i]);
            qrow[256 + i] = f2bf(x1 * cs - x2 * sn); qrow[272 + i] = f2bf(x1 * sn + x2 * cs);
        }
    }
    const int wave_qmax = q0 + wv * 32 + 31;
    const int wave_chunk = (q0 + wv * 32) >> 6;

    f32x16 O[DB];
#pragma unroll
    for (int d = 0; d < DB; ++d) O[d] = (f32x16){};
    float carry = (MODE == 0) ? 1.f : 0.f, mrun = -INFINITY, lrun = 0.f;

    constexpr int NH = (MODE == 2) ? 1 : 2;
    u32x4 stg[NH][NST];
    auto issue = [&](int kT) {
#pragma unroll
        for (int hf = 0; hf < NH; ++hf) {
            const int kt = kT * NH + hf;
#pragma unroll
            for (int i = 0; i < NST; ++i) {
                u32x4 w = {0u, 0u, 0u, 0u};
                if constexpr (MODE == 0) {
                    const int row = tid >> 3, ch = tid & 7, kk = kt * 64 + row;
                    const int off = (i == 0 ? 512 : 1024) + hd * 64 + ch * 8;
                    if (!samp) w = *(const u32x4*)(QKVG + (size_t)(b * 2048 + kk) * 3072 + off);
                    else if (kk < 4096) w = ld_f32x8_bf16(p.in[i == 0 ? 2 : 3] + (((size_t)b * 4096 + kk) * 8 + hd) * 64 + ch * 8);
                    else if (kk < 4112) w = *(const u32x4*)(QKVG + (size_t)(NP + b * 16 + kk - 4096) * 3072 + off);
                } else if constexpr (MODE == 1) {
                    if (i == 0) { const int row = tid >> 3, ch = tid & 7; w = *(const u32x4*)(KVUP + (size_t)(b * 2048 + kt * 64 + row) * 1024 + 512 + hd * 64 + ch * 8); }
                    else {
                        const int id = tid + (i - 1) * 512;
                        if (id < 768) { const int row = id / 12, ch = id % 12; const size_t gr = (size_t)(b * 2048 + kt * 64 + row);
                            w = ch < 8 ? *(const u32x4*)(KVUP + gr * 1024 + hd * 64 + ch * 8) : *(const u32x4*)(IN1 + gr * 1792 + 1664 + (ch - 8) * 8); }
                    }
                } else {
                    const int id = tid + i * 512;
                    if (id < 2304) { const int row = id / 36, ch = id % 36, kk = kt * 64 + row;
                        if (kk < 4112) w = *(const u32x4*)(KC + ((size_t)b * 4112 + kk) * 288 + ch * 8); }
                }
                stg[hf][i] = w;
            }
        }
    };
    auto commit = [&]() {
#pragma unroll
        for (int hf = 0; hf < NH; ++hf) {
            unsigned char* Kh = Ks + hf * 64 * C::KSTR; unsigned char* Vh = Vs + hf * 64 * C::VSTR;
#pragma unroll
            for (int i = 0; i < NST; ++i) {
                if constexpr (MODE == 0) { const int row = tid >> 3, ch = tid & 7; *(u32x4*)((i == 0 ? Kh + row * C::KSTR : Vh + row * C::VSTR) + ch * 16) = stg[hf][i]; }
                else if constexpr (MODE == 1) {
                    if (i == 0) { const int row = tid >> 3, ch = tid & 7; *(u32x4*)(Vh + row * C::VSTR + ch * 16) = stg[hf][0]; }
                    else { const int id = tid + (i - 1) * 512; if (id < 768) { const int row = id / 12, ch = id % 12; *(u32x4*)(Kh + row * C::KSTR + ch * 16) = stg[hf][i]; } }
                } else { const int id = tid + i * 512; if (id < 2304) { const int row = id / 36, ch = id % 36; *(u32x4*)(Kh + row * C::KSTR + ch * 16) = stg[hf][i]; } }
            }
        }
    };

    const int kT_last = kt_last / NH;
    issue(kT_last);
    int done = wactive ? 0 : 1, par = 0;
    for (int kT = kT_last; kT >= 0; --kT) {
        if constexpr (MODE == 0) { if (lane == 0) flags[par * 8 + wv] = done; }
        __syncthreads();
        if constexpr (MODE == 0) {
            int all = 1;
#pragma unroll
            for (int w = 0; w < 8; ++w) all &= flags[par * 8 + w];
            par ^= 1;
            if (all) break;
        }
        commit();
        __syncthreads();
        if (kT > 0) issue(kT - 1);
      f32x16 SA[NH][2]; bool relq[NH];
#pragma unroll
      for (int hfi = 0; hfi < NH; ++hfi) {
        const int hf = NH - 1 - hfi, kt = kT * NH + hf;
        unsigned char* Ks = smem + hf * 64 * C::KSTR;
        bool rel = wactive && (kt <= kt_last);
        if constexpr (MODE == 0) rel = rel && !done && (samp || kt * 64 < wave_qmax);
        if constexpr (MODE == 1) rel = rel && (kt <= wave_chunk);
        relq[hf] = rel;
        SA[hf][0] = (f32x16){}; SA[hf][1] = (f32x16){};
        if (rel) {
                constexpr int CH = (KS % 6 == 0) ? 6 : 4;
#pragma unroll
                for (int c0 = 0; c0 < KS; c0 += CH) {
                    bf16x8 ka[2][CH], qb[CH];
#pragma unroll
                    for (int s = 0; s < CH; ++s) {
                        ka[0][s] = *(const bf16x8*)(Ks + (r) * C::KSTR + ((c0 + s) * 16 + 8 * h) * 2);
                        ka[1][s] = *(const bf16x8*)(Ks + (32 + r) * C::KSTR + ((c0 + s) * 16 + 8 * h) * 2);
                        if constexpr (MODE == 2) qb[s] = *(const bf16x8*)(Qs + (rg * 32 + r) * 592 + ((c0 + s) * 16 + 8 * h) * 2); else qb[s] = qf[c0 + s];
                    }
                    __builtin_amdgcn_sched_barrier(0);
#pragma unroll
                    for (int s = 0; s < CH; ++s) {
                        SA[hf][0] = __builtin_amdgcn_mfma_f32_32x32x16_bf16(ka[0][s], qb[s], SA[hf][0], 0, 0, 0);
                        SA[hf][1] = __builtin_amdgcn_mfma_f32_32x32x16_bf16(ka[1][s], qb[s], SA[hf][1], 0, 0, 0);
                    }
                }
        }
      }
#pragma unroll
      for (int hfi = 0; hfi < NH; ++hfi) {
        const int hf = NH - 1 - hfi, kt = kT * NH + hf;
        unsigned char* Vs = ((MODE == 2) ? smem : smem + SM_V) + hf * 64 * C::VSTR;
        bool rel = relq[hf];
        if constexpr (MODE == 0) rel = rel && !done;
        if (rel) {
            f32x16 (&S)[2] = SA[hf];
            bf16x8 pf[2][2];
            if constexpr (MODE == 0) {
#pragma unroll
                for (int kbi = 0; kbi < 2; ++kbi) {
                    const int kb = 1 - kbi;
                    float bt[16], qv[16];
#pragma unroll
                    for (int reg = 0; reg < 16; ++reg) {
                        const int kk = kt * 64 + kb * 32 + (reg & 3) + 8 * (reg >> 2) + 4 * h;
                        const bool v = qvalid && (kk < qpos);
                        const float t = __builtin_amdgcn_exp2f(fminf(S[kb][reg], 120.f));
                        const float q = __builtin_amdgcn_rcpf(1.f + t);
                        bt[reg] = v ? t * q : 0.f; qv[reg] = v ? q : 1.f;
                    }
                    float G[4], PG[4], T[4];
#pragma unroll
                    for (int g = 0; g < 4; ++g) { G[g] = (qv[4 * g] * qv[4 * g + 1]) * (qv[4 * g + 2] * qv[4 * g + 3]); PG[g] = __shfl_xor(G[g], 32); }
                    T[3] = 1.f; T[2] = G[3] * PG[3]; T[1] = T[2] * (G[2] * PG[2]); T[0] = T[1] * (G[1] * PG[1]);
                    const float total = T[0] * (G[0] * PG[0]);
                    float w[16];
#pragma unroll
                    for (int g = 0; g < 4; ++g) {
                        float run = carry * T[g] * (h == 0 ? PG[g] : 1.f);
#pragma unroll
                        for (int i = 3; i >= 0; --i) {
                            const int reg = 4 * g + i;
                            w[reg] = bt[reg] * run;
                            run *= qv[reg];
                        }
                    }
                    carry *= total;
#pragma unroll
                    for (int s = 0; s < 2; ++s) {
                        u32x4 u; u.x = pk2(w[8 * s], w[8 * s + 1]); u.y = pk2(w[8 * s + 2], w[8 * s + 3]); u.z = pk2(w[8 * s + 4], w[8 * s + 5]); u.w = pk2(w[8 * s + 6], w[8 * s + 7]);
                        pf[kb][s] = __builtin_bit_cast(bf16x8, u);
                    }
                }
                done = __all((!qvalid) || (carry < 1e-36f)) ? 1 : 0;
            } else {
                float mx = -INFINITY;
#pragma unroll
                for (int kb = 0; kb < 2; ++kb)
#pragma unroll
                    for (int reg = 0; reg < 16; ++reg) {
                        if constexpr (MODE == 2) { const int kk = kt * 64 + kb * 32 + (reg & 3) + 8 * (reg >> 2) + 4 * h; if (kk >= 4112) S[kb][reg] = -INFINITY; }
                        mx = fmaxf(mx, S[kb][reg]);
                    }
                mx = fmaxf(mx, __shfl_xor(mx, 32));
                const float mn = fmaxf(mrun, mx);
                const float alpha = __builtin_amdgcn_exp2f(mrun - mn);
                mrun = mn;
                float ls = 0.f;
#pragma unroll
                for (int kb = 0; kb < 2; ++kb) {
                    float w[16];
#pragma unroll
                    for (int reg = 0; reg < 16; ++reg) { w[reg] = __builtin_amdgcn_exp2f(S[kb][reg] - mn); ls += w[reg]; }
#pragma unroll
                    for (int s = 0; s < 2; ++s) {
                        u32x4 u; u.x = pk2(w[8 * s], w[8 * s + 1]); u.y = pk2(w[8 * s + 2], w[8 * s + 3]); u.z = pk2(w[8 * s + 4], w[8 * s + 5]); u.w = pk2(w[8 * s + 6], w[8 * s + 7]);
                        pf[kb][s] = __builtin_bit_cast(bf16x8, u);
                    }
                }
                lrun = lrun * alpha + ls;
                if (!__all(alpha == 1.f)) {
#pragma unroll
                    for (int d = 0; d < DB; ++d) O[d] = O[d] * alpha;
                }
            }
#pragma unroll
            for (int d = 0; d < DB; ++d) {
                bf16x8 va[2][2];
#pragma unroll
                for (int kb = 0; kb < 2; ++kb)
#pragma unroll
                    for (int s = 0; s < 2; ++s) {
                        const unsigned char* vp = Vs + (kb * 32 + 16 * s + 4 * h + q4) * C::VSTR + ((dvh * 4 + d) * 32 + 16 * (grp & 1) + 4 * pp) * 2;
                        s4v lo = tr_read(vp), hi = tr_read(vp + 8 * C::VSTR);
                        va[kb][s] = __builtin_shufflevector(lo, hi, 0, 1, 2, 3, 4, 5, 6, 7);
                    }
                __builtin_amdgcn_sched_barrier(0);
#pragma unroll
                for (int kb = 0; kb < 2; ++kb)
#pragma unroll
                    for (int s = 0; s < 2; ++s) O[d] = __builtin_amdgcn_mfma_f32_32x32x16_bf16(va[kb][s], pf[kb][s], O[d], 0, 0, 0);
            }
        }
      }
    }
    if (MODE == 0 || MODE == 1) {
        float inv = 1.f;
        if constexpr (MODE == 1) { const float l = lrun + __shfl_xor(lrun, 32); inv = 1.f / l; }
        if (wactive && qvalid) {
            bf16_t* op = (MODE == 0) ? (bf16_t*)(p.ws + WS_R1 + R1_MIXED) + orow * 1024 + hd * 64
                                     : (bf16_t*)(p.ws + WS_R1 + R1_MIXED2) + orow * 1024 + 512 + hd * 64;
#pragma unroll
            for (int d = 0; d < DB; ++d)
#pragma unroll
                for (int g = 0; g < 4; ++g) {
                    u32x2 w; w.x = pk2(O[d][4 * g] * inv, O[d][4 * g + 1] * inv); w.y = pk2(O[d][4 * g + 2] * inv, O[d][4 * g + 3] * inv);
                    *(u32x2*)(op + d * 32 + 8 * g + 4 * h) = w;
                }
        }
    } else {
        const float l = lrun + __shfl_xor(lrun, 32);
        const float inv = 1.f / l;
        __syncthreads();
        float* OL = (float*)smem;
        if (wactive) {
            const int rr = rg * 32 + r;
#pragma unroll
            for (int d = 0; d < DB; ++d)
#pragma unroll
                for (int g = 0; g < 4; ++g)
                    *(f32x4*)(OL + rr * 256 + (dvh * 4 + d) * 32 + 8 * g + 4 * h) = (f32x4){O[d][4 * g] * inv, O[d][4 * g + 1] * inv, O[d][4 * g + 2] * inv, O[d][4 * g + 3] * inv};
        }
        __syncthreads();
        const int hh = tid >> 6, v = tid & 63;
        const float* wuv = p.in[23] + (size_t)hh * 256 * 64 + v;
        float acc[16];
#pragma unroll
        for (int t = 0; t < 16; ++t) acc[t] = 0.f;
        for (int c = 0; c < 256; ++c) {
            const float w = wuv[(size_t)c * 64];
#pragma unroll
            for (int t = 0; t < 16; ++t) acc[t] += OL[(hh * 16 + t) * 256 + c] * w;
        }
        bf16_t* MX = (bf16_t*)(p.ws + WS_R1 + R1_MIXED2);
#pragma unroll
        for (int t = 0; t < 16; ++t) MX[(size_t)(NP + b * 16 + t) * 1024 + 512 + hh * 64 + v] = f2bf(acc[t]);
    }
}

#define XB_TMO      128
#define XB_XCNT(j)  (256  + 64 * (j))
#define XB_XSUB(j)  (1280 + 64 * (j))
#define XB_XGEN(j)  (2304 + 64 * (j))
#define XB_TOP      3328
#define XB_TOPGEN   3392
#define XCD_BAR_WORDS 3456
#define XB_SPIN_CAP (1u << 21)
DEVI unsigned xb_ld(unsigned* p)              { return __hip_atomic_load(p, __ATOMIC_RELAXED, __HIP_MEMORY_SCOPE_AGENT); }
DEVI unsigned xb_add(unsigned* p, unsigned v) { return __hip_atomic_fetch_add(p, v, __ATOMIC_RELAXED, __HIP_MEMORY_SCOPE_AGENT); }
DEVI unsigned xb_xcc_id() { return (unsigned)__builtin_amdgcn_s_getreg((3 << 11) | 20) & 0xFu; }
#define XB_SPIN(cond, bar) do { unsigned _sp = 0; while (cond) { __builtin_amdgcn_s_sleep(1); \
    if ((++_sp & 255u) == 0u) { if (xb_ld(&(bar)[XB_TMO])) break; if (_sp > XB_SPIN_CAP) { atomicAdd(&(bar)[XB_TMO], 1u); break; } } } } while (0)
struct XcdBarrier { unsigned* bar; unsigned x; volatile LAS unsigned* st; };
DEVI XcdBarrier xcd_barrier_post(unsigned* bar, volatile LAS unsigned* st) {
    XcdBarrier b; b.bar = bar; b.x = xb_xcc_id(); b.st = st;
    if (threadIdx.x == 0) (void)xb_add(&bar[XB_XCNT(b.x)], 1u);
    return b;
}
DEVI void xcd_barrier_complete(unsigned* bar, unsigned x, unsigned& nloc, unsigned& nx) {
    const unsigned G = gridDim.x * gridDim.y * gridDim.z;
    unsigned sum, cnt, mine, sp = 0u;
    for (;;) {
        sum = 0u; cnt = 0u; mine = 0u;
#pragma unroll
        for (unsigned j = 0; j < 16; ++j) { const unsigned c = xb_ld(&bar[XB_XCNT(j)]); sum += c; cnt += (c > 0u) ? 1u : 0u; mine = (j == x) ? c : mine; }
        if (sum == G) break;
        __builtin_amdgcn_s_sleep(1);
        if ((++sp & 255u) == 0u) { if (xb_ld(&bar[XB_TMO])) break; if (sp > XB_SPIN_CAP) { atomicAdd(&bar[XB_TMO], 1u); break; } }
    }
    nloc = mine > 0u ? mine : 1u; nx = cnt > 0u ? cnt : 1u;
}
DEVI void xcd_barrier(const XcdBarrier& b) {
    asm volatile("s_waitcnt vmcnt(0)" ::: "memory");
    __syncthreads();
    if (threadIdx.x == 0) {
        unsigned* bar = b.bar;
        __builtin_amdgcn_s_waitcnt(0);
        unsigned nloc = b.st[0], nx = b.st[1];
        if (nloc == 0u) { xcd_barrier_complete(bar, b.x, nloc, nx); b.st[0] = nloc; b.st[1] = nx; }
        const unsigned old = xb_add(&bar[XB_XSUB(b.x)], 1u);
        const unsigned gen = old / nloc;
        if (old + 1u == (gen + 1u) * nloc) {
            __builtin_amdgcn_fence(__ATOMIC_RELEASE, "agent");
            asm volatile("s_waitcnt vmcnt(0)" ::: "memory");
            const unsigned og = xb_add(&bar[XB_TOP], 1u);
            const unsigned tg = og / nx;
            if (og + 1u == (tg + 1u) * nx) xb_add(&bar[XB_TOPGEN], 1u);
            else XB_SPIN(xb_ld(&bar[XB_TOPGEN]) == tg, bar);
            __builtin_amdgcn_fence(__ATOMIC_ACQUIRE, "agent");
            xb_add(&bar[XB_XGEN(b.x)], 1u);
            asm volatile("s_waitcnt vmcnt(0)" ::: "memory");
        } else {
            XB_SPIN(xb_ld(&bar[XB_XGEN(b.x)]) == gen, bar);
            __builtin_amdgcn_fence(__ATOMIC_ACQUIRE, "agent");
            asm volatile("s_waitcnt vmcnt(0)" ::: "memory");
        }
    }
    __syncthreads();
}

DEVI int next_item(unsigned* ctr, int* slot) {
    __syncthreads();
    if (threadIdx.x == 0) *slot = (int)atomicAdd(ctr, 1u);
    __syncthreads();
    return *slot;
}

__global__ void __launch_bounds__(512) mega(Params p, int ph_lo, int ph_hi, int coop) {
    __shared__ __attribute__((aligned(16))) unsigned char smem[131072 + 64];
    int* const s_item_p = (int*)(smem + 131072);
    unsigned* const xbw = (unsigned*)(smem + 131072 + 16);
    if (threadIdx.x == 0) { xbw[0] = 0u; xbw[1] = 0u; xbw[2] = 0u; xbw[3] = 0u; }
    __syncthreads();
    XcdBarrier xb = xcd_barrier_post((unsigned*)(p.ws + WS_CTR), (volatile LAS unsigned*)xbw);
    unsigned* ctr = (unsigned*)(p.ws + WS_CTR);
    bf16_t* shm = (bf16_t*)smem;
    unsigned char* ws = p.ws;
    bf16_t* H = (bf16_t*)(ws + WS_H);
    bf16_t* Ob = (bf16_t*)(ws + WS_O);
    bf16_t* R1 = (bf16_t*)(ws + WS_R1);

    for (int ph = ph_lo; ph < ph_hi; ++ph) {
        if (ph > ph_lo && coop) { if (ph == 1) cg::this_grid().sync(); else xcd_barrier(xb); }
        const int layer = ph >= 8 ? 1 : 0;
        constexpr int rep = 0;
        switch (ph) {
        case 0: phase_prep(p, (float*)smem); break;
        case 1: {
            bf16_t* Q = R1;
            const bf16_t* W = (const bf16_t*)(ws + WS_W1T);
            auto emit = [&](int row, int col, f32x4 v0, f32x4 v1) { bf16_t* d = Q + (size_t)row * 3072 + col; st_bf16x8(d, v0, v1); };
            gemm_run<16>(H, 1024, W, 1024, 1024, shm, [&](int i, int& br, int& bc) { const int it = blockIdx.x + i * gridDim.x; if (it >= 256 * 12) return false; int pm, pn; tile_map(it, 256, 12, pm, pn); br = pm * 256; bc = pn * 256; return true; }, emit);
            for (int it = blockIdx.x; it < 8 * 48; it += gridDim.x) gemm_small<8>(H, 1024, W, 1024, 1024, NP + (it & 7) * 64, (it >> 3) * 64, (float*)smem, emit);
        } break;
        case 2: {
            for (;;) {
                const int it = next_item(ctr + 0 + 2 * rep, s_item_p);
                if (it >= 2304 + 2064 + 1152) break;
                if (it >= 2304 + 2064) { kc_item(p, it - (2304 + 2064)); continue; }
                if (it < 2 * 2064) { if (it & 1) conv_item(p, it >> 1); else attn_item<0>(p, it >> 1, smem); }
                else attn_item<0>(p, it - 2064, smem);
            }
        } break;
        case 3: case 12: {
            const bf16_t* A = R1 + (layer ? R1_MIXED2 : R1_MIXED) / 2;
            const bf16_t* W = (const bf16_t*)(ws + (layer ? WS_WO2T : WS_WO1T));
            auto emit = [&](int row, int col, f32x4 v0, f32x4 v1) { bf16_t* d = Ob + (size_t)row * 1024 + col; st_bf16x8(d, v0, v1); };
            gemm_run<16>(A, 1024, W, 1024, 1024, shm, [&](int i, int& br, int& bc) { const int it = blockIdx.x + i * gridDim.x; if (it >= 256 * 4) return false; int pm, pn; tile_map(it, 256, 4, pm, pn); br = pm * 256; bc = pn * 256; return true; }, emit);
            for (int it = blockIdx.x; it < 8 * 16; it += gridDim.x) gemm_small<8>(A, 1024, W, 1024, 1024, NP + (it & 7) * 64, (it >> 3) * 64, (float*)smem, emit);
        } break;
        case 4: phase_rowpass(p, false, p.in[8], false); break;
        case 13: phase_rowpass(p, false, p.in[8] + 1024, false); break;
        case 5: case 14: {
            bf16_t* ACT = R1;
            const bf16_t* W = (const bf16_t*)(ws + (layer ? WS_WUP1 : WS_WUP0));
            auto emit = [&](int row, int col, f32x4 v0, f32x4 v1) {
#pragma unroll
                for (int k = 0; k < 4; ++k) { float a = fmaxf(v0[k], 0.f), b2 = fmaxf(v1[k], 0.f); v0[k] = a * a; v1[k] = b2 * b2; }
                bf16_t* d = ACT + (size_t)row * 4096 + col; st_bf16x8(d, v0, v1);
            };
            gemm_run<16>(H, 1024, W, 1024, 1024, shm, [&](int i, int& br, int& bc) { const int it = blockIdx.x + i * gridDim.x; if (it >= 256 * 16) return false; int pm, pn; tile_map(it, 256, 16, pm, pn); br = pm * 256; bc = pn * 256; return true; }, emit);
            for (int it = blockIdx.x; it < 8 * 64; it += gridDim.x) gemm_small<8>(H, 1024, W, 1024, 1024, NP + (it & 7) * 64, (it >> 3) * 64, (float*)smem, emit);
        } break;
        case 6: case 15: {
            const bf16_t* ACT = R1;
            const bf16_t* W = (const bf16_t*)(ws + (layer ? WS_WDN1 : WS_WDN0));
            auto emit = [&](int row, int col, f32x4 v0, f32x4 v1) { bf16_t* d = Ob + (size_t)row * 1024 + col; st_bf16x8(d, v0, v1); };
            gemm_run<16>(ACT, 4096, W, 4096, 4096, shm, [&](int i, int& br, int& bc) { if (i >= 4) return false; const int it = blockIdx.x + (3 - i) * gridDim.x;     int pm, pn; tile_map(it, 256, 4, pm, pn); br = pm * 256; bc = pn * 256; return true; }, emit);
            for (int it = blockIdx.x; it < 8 * 16; it += gridDim.x) gemm_small<8>(ACT, 4096, W, 4096, 4096, NP + (it & 7) * 64, (it >> 3) * 64, (float*)smem, emit);
        } break;
        case 7: phase_rowpass(p, false, p.in[10], false); break;
        case 16: phase_rowpass(p, false, p.in[10] + 1024, true); break;
        case 8: {
            bf16_t* IN1 = R1;
            const bf16_t* W = (const bf16_t*)(ws + WS_W2T);
            auto emit = [&](int row, int col, f32x4 v0, f32x4 v1) { bf16_t* d = IN1 + (size_t)row * 1792 + col; st_bf16x8(d, v0, v1); };
            gemm_run<16>(H, 1024, W, 1024, 1024, shm, [&](int i, int& br, int& bc) { const int it = blockIdx.x + i * gridDim.x; if (it >= 256 * 7) return false; int pm, pn; tile_map(it, 256, 7, pm, pn); br = pm * 256; bc = pn * 256; return true; }, emit);
            for (int it = blockIdx.x; it < 8 * 28; it += gridDim.x) gemm_small<8>(H, 1024, W, 1024, 1024, NP + (it & 7) * 64, (it >> 3) * 64, (float*)smem, emit);
        } break;
        case 9: phase_l1rows(p); break;
        case 10: {
            const bf16_t* IN1 = R1;
            bf16_t* QF = R1 + R1_QF / 2; bf16_t* KVUP = R1 + R1_KVUP / 2; bf16_t* QLAT = R1 + R1_QLAT / 2;
            auto emit_kv = [&](int row, int col, f32x4 v0, f32x4 v1) { bf16_t* d = KVUP + (size_t)row * 1024 + col; st_bf16x8(d, v0, v1); };
            auto emit_qf = [&](int row, int col, f32x4 v0, f32x4 v1) { bf16_t* d = QF + (size_t)row * 768 + col; st_bf16x8(d, v0, v1); };
            auto emit_ql = [&](int row, int col, f32x4 v0, f32x4 v1) { bf16_t* d = QLAT + (size_t)(row - NP) * 2048 + col; st_bf16x8(d, v0, v1); };
            gemm_run<0>(IN1 + 1408, 1792, (const bf16_t*)(ws + WS_WKVT), 256, 256, shm, [&](int i, int& br, int& bc) { const int it = blockIdx.x + i * gridDim.x; if (it >= 256 * 4) return false; int pm, pn; tile_map(it, 256, 4, pm, pn); br = pm * 256; bc = pn * 256; return true; }, emit_kv);
            gemm_run<0>(IN1 + 1024, 1792, (const bf16_t*)(ws + WS_WUQT), 384, 384, shm, [&](int i, int& br, int& bc) { const int it = blockIdx.x + i * gridDim.x; if (it >= 256 * 3) return false; int pm, pn; tile_map(it, 256, 3, pm, pn); br = pm * 256; bc = pn * 256; return true; }, emit_qf);
            for (int it = blockIdx.x; it < 8 * 12 + 8 * 32; it += gridDim.x) {
                if (it < 96) gemm_small<4>(IN1 + 1024, 1792, (const bf16_t*)(ws + WS_WUQT), 384, 384, NP + (it & 7) * 64, (it >> 3) * 64, (float*)smem, emit_qf);
                else { const int i2 = it - 96; gemm_small<4>(IN1 + 1024, 1792, (const bf16_t*)(ws + WS_WQLT), 384, 384, NP + (i2 & 7) * 64, (i2 >> 3) * 64, (float*)smem, emit_ql); }
            }
        } break;
        case 11: {
            for (;;) {
                int it = next_item(ctr + 1 + 2 * rep, s_item_p);
                if (it >= 32 + 2048 + 2176) break;
                if (it < 32) attn_item<2>(p, it, smem);
                else {
                    const int i2 = it - 32;
                    if (i2 < 2 * 2048) { if (i2 & 1) sgu_item(p, i2 >> 1, smem); else attn_item<1>(p, i2 >> 1, smem); }
                    else sgu_item(p, i2 - 2048, smem);
                }
            }
        } break;
        default: break;
        }
    }
}

constexpr int NPHASE = 17;

extern "C" void kernel_launch(void* const* d_in, const int* in_sizes, int n_in, void* d_out, int out_size, void* d_ws, size_t ws_size, hipStream_t stream) {
    static int grid = 0;
    if (grid == 0) {
        int dev = 0, cus = 0, per_cu = 0;
        hipGetDevice(&dev);
        hipDeviceGetAttribute(&cus, hipDeviceAttributeMultiprocessorCount, dev);
        hipOccupancyMaxActiveBlocksPerMultiprocessor(&per_cu, mega, 512, 0);
        if (per_cu < 1) per_cu = 1;
        grid = cus * 1;
        if (ws_size < WS_END) { fprintf(stderr, "kernel_launch: workspace too small: %zu < %zu\n", ws_size, (size_t)WS_END); grid = -1; }
    }
    if (grid < 0) return;
    Params p{};
    for (int i = 0; i < 27; ++i) p.in[i] = (const float*)d_in[i];
    p.out = (float*)d_out; p.ws = (unsigned char*)d_ws;
    hipMemsetAsync(d_ws, 0, 16384, stream);
#ifdef MULTI_LAUNCH
    for (int ph = 0; ph < NPHASE; ++ph) hipLaunchKernelGGL(mega, dim3(grid), dim3(512), 0, stream, p, ph, ph + 1, 0);
#else
    int lo = 0, hi = NPHASE, coop = 1;
    void* args[] = {&p, &lo, &hi, &coop};
    hipError_t e = hipLaunchCooperativeKernel((void*)mega, dim3(grid), dim3(512), args, 0, stream);
    if (e != hipSuccess) fprintf(stderr, "cooperative launch failed: %s (grid %d)\n", hipGetErrorString(e), grid);
#endif
}
```

```cpp
#include <hip/hip_runtime.h>
#include <hip/hip_cooperative_groups.h>
#include <cstdio>
#include <cstdint>
namespace cg = cooperative_groups;

#define DEVI __device__ __forceinline__
typedef unsigned short bf16_t;
typedef short bf16x8 __attribute__((ext_vector_type(8)));
typedef short s4v __attribute__((ext_vector_type(4)));
typedef float f32x4 __attribute__((ext_vector_type(4)));
typedef float f32x16 __attribute__((ext_vector_type(16)));
typedef unsigned u32x4 __attribute__((ext_vector_type(4)));
typedef unsigned u32x2 __attribute__((ext_vector_type(2)));

constexpr int NP = 65536;
constexpr int NS = 512;
constexpr int MT = NP + NS;
constexpr float EPS = 1e-6f;
constexpr float LOG2E = 1.4426950408889634f;
constexpr float SBQ = 0.125f * LOG2E;
constexpr float MLQ = 0.10206207261596577f * LOG2E;

constexpr size_t O_Y = 0;
constexpr size_t O_SBK_P = (size_t)MT * 1024;
constexpr size_t O_SBV_P = O_SBK_P + (size_t)NP * 512;
constexpr size_t O_CONV_P = O_SBV_P + (size_t)NP * 512;
constexpr size_t O_CKV_P = O_CONV_P + 32 * 2 * 512;
constexpr size_t O_KPE_P = O_CKV_P + (size_t)NP * 256;
constexpr size_t O_SBK_S = O_KPE_P + (size_t)NP * 32;
constexpr size_t O_SBV_S = O_SBK_S + (size_t)NS * 512;
constexpr size_t O_CONV_S = O_SBV_S + (size_t)NS * 512;
constexpr size_t O_CKV_S = O_CONV_S + 32 * 2 * 512;
constexpr size_t O_KPE_S = O_CKV_S + (size_t)NS * 256;
constexpr size_t O_SGUV_S = O_KPE_S + (size_t)NS * 32;

constexpr size_t WS_CTR = 0;
constexpr size_t WS_W1T = 16384;
constexpr size_t WS_WO1T = WS_W1T + 3072ull * 1024 * 2;
constexpr size_t WS_WUP0 = WS_WO1T + 1024ull * 1024 * 2;
constexpr size_t WS_WDN0 = WS_WUP0 + 4096ull * 1024 * 2;
constexpr size_t WS_WUP1 = WS_WDN0 + 4096ull * 1024 * 2;
constexpr size_t WS_WDN1 = WS_WUP1 + 4096ull * 1024 * 2;
constexpr size_t WS_W2T = WS_WDN1 + 4096ull * 1024 * 2;
constexpr size_t WS_WUQT = WS_W2T + 1792ull * 1024 * 2;
constexpr size_t WS_WKVT = WS_WUQT + 768ull * 384 * 2;
constexpr size_t WS_WQLT = WS_WKVT + 1024ull * 256 * 2;
constexpr size_t WS_WO2T = WS_WQLT + 2048ull * 384 * 2;
constexpr size_t WS_H = WS_WO2T + 1024ull * 1024 * 2;
constexpr size_t WS_O = WS_H + (size_t)MT * 1024 * 2;
constexpr size_t WS_KC = WS_O + (size_t)MT * 1024 * 2;
constexpr size_t WS_R1 = WS_KC + 32ull * 4112 * 288 * 2;
constexpr size_t R1_QKVG = 0;
constexpr size_t R1_MIXED = (size_t)MT * 3072 * 2;
constexpr size_t R1_ACT = 0;
constexpr size_t R1_IN1 = 0;
constexpr size_t R1_QF = (size_t)MT * 1792 * 2;
constexpr size_t R1_KVUP = R1_QF + (size_t)MT * 768 * 2;
constexpr size_t R1_QLAT = R1_KVUP + (size_t)MT * 1024 * 2;
constexpr size_t R1_MIXED2 = R1_QLAT + 512ull * 2048 * 2;
constexpr size_t WS_RS = WS_R1 + R1_MIXED2 + (size_t)MT * 1024 * 2;
constexpr size_t WS_END = WS_RS + (size_t)MT * 4;

struct Params {
    const float* in[27];
    float* out;
    unsigned char* ws;
};

typedef __bf16 bf2v __attribute__((ext_vector_type(2)));
DEVI unsigned short f2bf(float f) { __bf16 v = (__bf16)f; return __builtin_bit_cast(unsigned short, v); }
DEVI unsigned pk2(float a, float b) { bf2v v = {(__bf16)a, (__bf16)b}; return __builtin_bit_cast(unsigned, v); }
DEVI float bflo(unsigned w) { return __uint_as_float(w << 16); }
DEVI float bfhi(unsigned w) { return __uint_as_float(w & 0xffff0000u); }
DEVI float bf2f(unsigned short h) { return __uint_as_float(((unsigned)h) << 16); }
DEVI float wave_sum(float v) {
#pragma unroll
    for (int o = 32; o > 0; o >>= 1) v += __shfl_xor(v, o);
    return v;
}
DEVI void unpack8(u32x4 w, float* f) {
    f[0] = bflo(w.x); f[1] = bfhi(w.x); f[2] = bflo(w.y); f[3] = bfhi(w.y);
    f[4] = bflo(w.z); f[5] = bfhi(w.z); f[6] = bflo(w.w); f[7] = bfhi(w.w);
}
DEVI u32x4 pack8(const float* f) { u32x4 w; w.x = pk2(f[0], f[1]); w.y = pk2(f[2], f[3]); w.z = pk2(f[4], f[5]); w.w = pk2(f[6], f[7]); return w; }
DEVI int get_tid() { int t = threadIdx.x; asm volatile("" : "+v"(t)); return t; }
DEVI int row_pos(int row) { return row < NP ? (row & 2047) : 4096 + ((row - NP) & 15); }

constexpr int BM = 256, BK = 64, HALF = 128, HT = HALF * BK;
DEVI int lds_byte(int r, int c) {
    int st = (r >> 4) * 2 + (c >> 5), rr = r & 15, cc = c & 31, ob = rr * 64 + cc * 2;
    return st * 1024 + (ob ^ (((ob >> 9) & 1) << 5));
}
DEVI void stage_rc(int b, int& R, int& C) {
    int st = b / 1024, sb = b % 1024, swz = sb ^ (((sb >> 9) & 1) << 5);
    R = (st >> 1) * 16 + swz / 64; C = (st & 1) * 32 + (swz % 64) / 2;
}

#define LAS __attribute__((address_space(3)))
template <int NSTORE, class TF, class F>
DEVI void gemm_run(const bf16_t* __restrict__ A, int lda, const bf16_t* __restrict__ Bt, int ldb, int K, bf16_t* shm, TF&& tile, F&& emit) {
    LAS unsigned char* lds = (LAS unsigned char*)shm;
    const int tid = get_tid(), wid = __builtin_amdgcn_readfirstlane(tid >> 6), lane = tid & 63, wr = wid >> 2, wc = wid & 3, fr = lane & 15, fq = lane >> 4;
    const int nt = K / BK;
    unsigned voffA[2], voffB[2];
#pragma unroll
    for (int i = 0; i < 2; ++i) { int R, C; stage_rc(tid * 16 + i * 8192, R, C); const int rho = R & 31; const int Rb = (R & ~31) + (8 * ((rho & 15) >> 2) + 4 * (rho >> 4) + (rho & 3));
        voffA[i] = (unsigned)(R * lda + C) * 2u; voffB[i] = (unsigned)(Rb * ldb + C) * 2u; }
    const size_t kstep = (size_t)(BK * 2);
    const size_t hstepA = (size_t)HALF * lda * 2, hstepB = (size_t)HALF * ldb * 2;
    const unsigned ldsw = (unsigned)wid * 1024u;
    const int aoff = lds_byte(wr * 64 + fr, fq * 8), boff = lds_byte(wc * 32 + fr, fq * 8);
    constexpr int HTB = HALF * BK * 2;
#define G_SA(b, h) (((b) * 2 + (h)) * HTB)
#define G_SB(b, h) ((4 + (b) * 2 + (h)) * HTB)
#define G_STAGE(bufoff, gbase, voff) do { _Pragma("unroll") for (int _i = 0; _i < 2; ++_i) \
        __builtin_amdgcn_global_load_lds((const unsigned*)((const char*)(gbase) + (voff)[_i]), (LAS unsigned*)(lds + (bufoff) + ldsw + _i * 8192), 16, 0, 0); } while (0)
#define G_LDA(dst, b, h) do { _Pragma("unroll") for (int m = 0; m < 4; ++m) _Pragma("unroll") for (int k = 0; k < 2; ++k) dst[m][k] = *(const LAS bf16x8*)(lds + G_SA(b, h) + aoff + m * 2048 + k * 1024); } while (0)
#define G_LDB(dst, b, h) do { _Pragma("unroll") for (int n = 0; n < 2; ++n) _Pragma("unroll") for (int k = 0; k < 2; ++k) dst[n][k] = *(const LAS bf16x8*)(lds + G_SB(b, h) + boff + n * 2048 + k * 1024); } while (0)
#define G_MMA(ai, bj, At, Bt_) do { __builtin_amdgcn_s_setprio(1); _Pragma("unroll") for (int m = 0; m < 4; ++m) _Pragma("unroll") for (int n = 0; n < 2; ++n) _Pragma("unroll") for (int k = 0; k < 2; ++k) \
        acc[ai][bj][m][n] = __builtin_amdgcn_mfma_f32_16x16x32_bf16(Bt_[n][k], At[m][k], acc[ai][bj][m][n], 0, 0, 0); __builtin_amdgcn_s_setprio(0); } while (0)
#define G_WAIT_V(n) asm volatile("s_waitcnt vmcnt(" #n ")" ::: "memory")
#define G_WAIT_L(n) asm volatile("s_waitcnt lgkmcnt(" #n ")" ::: "memory")
#define G_BAR __builtin_amdgcn_s_barrier()
#define G_SCHED __builtin_amdgcn_sched_barrier(0)
    int brow, bcol, nrow, ncol; int ui = 0;
    if (!tile(0, brow, bcol)) return;
    f32x4 acc[2][2][4][2];
#pragma unroll
    for (int a = 0; a < 2; ++a)
#pragma unroll
        for (int b = 0; b < 2; ++b)
#pragma unroll
            for (int m = 0; m < 4; ++m)
#pragma unroll
                for (int n = 0; n < 2; ++n) acc[a][b][m][n] = (f32x4){0.f, 0.f, 0.f, 0.f};
    bf16x8 At[4][2], B0[2][2], B1[2][2];
    const char* cA = (const char*)A + (size_t)brow * lda * 2; const char* cB = (const char*)Bt + (size_t)bcol * ldb * 2;
    G_STAGE(G_SB(0, 0), cB, voffB); G_STAGE(G_SB(0, 1), cB + hstepB, voffB); G_STAGE(G_SA(0, 0), cA, voffA); G_STAGE(G_SA(0, 1), cA + hstepA, voffA);
    if (wr == 1) G_BAR;
    G_WAIT_V(2); G_BAR;
    G_STAGE(G_SB(1, 0), cB + kstep, voffB); G_STAGE(G_SA(1, 0), cA + kstep, voffA); G_STAGE(G_SB(1, 1), cB + hstepB + kstep, voffB);
    G_WAIT_V(6); G_BAR;
    for (;;) {
        const bool has_next = tile(ui + 1, nrow, ncol);
        const char* nA = has_next ? (const char*)A + (size_t)nrow * lda * 2 : cA; const char* nB = has_next ? (const char*)Bt + (size_t)ncol * ldb * 2 : cB;
        for (int t = 0; t < nt; t += 2) {
            const bool last = (t == nt - 2);
            const char* a1 = cA + (size_t)(t + 1) * kstep;
            const char* a2 = last ? nA : cA + (size_t)(t + 2) * kstep; const char* b2 = last ? nB : cB + (size_t)(t + 2) * kstep;
            const char* a3 = a2 + kstep; const char* b3 = b2 + kstep;
            G_LDB(B0, 0, 0); G_LDB(B1, 0, 1); G_SCHED; G_LDA(At, 0, 0); G_STAGE(G_SA(1, 1), a1 + hstepA, voffA);
            G_WAIT_V(8); G_WAIT_L(0); G_BAR; G_MMA(0, 0, At, B0); G_MMA(0, 1, At, B1); G_BAR; G_SCHED;
            G_LDA(At, 0, 1); G_STAGE(G_SB(0, 0), b2, voffB); G_STAGE(G_SB(0, 1), b2 + hstepB, voffB); G_STAGE(G_SA(0, 0), a2, voffA);
            G_WAIT_V(8); G_WAIT_L(0); G_BAR; G_MMA(1, 0, At, B0); G_MMA(1, 1, At, B1); G_BAR; G_SCHED;
            G_LDB(B0, 1, 0); G_LDB(B1, 1, 1); G_SCHED; G_LDA(At, 1, 0); G_STAGE(G_SA(0, 1), a2 + hstepA, voffA);
            G_WAIT_V(8); G_WAIT_L(0); G_BAR; G_MMA(0, 0, At, B0); G_MMA(0, 1, At, B1); G_BAR; G_SCHED;
            G_LDA(At, 1, 1); G_STAGE(G_SB(1, 0), b3, voffB); G_STAGE(G_SB(1, 1), b3 + hstepB, voffB); G_STAGE(G_SA(1, 0), a3, voffA);
            G_WAIT_V(8); G_WAIT_L(0); G_BAR; G_MMA(1, 0, At, B0); G_MMA(1, 1, At, B1); G_BAR; G_SCHED;
        }
        if (NSTORE != 0 && wr == 0) G_BAR;
#pragma unroll
        for (int ai = 0; ai < 2; ++ai)
#pragma unroll
            for (int m = 0; m < 4; ++m)
#pragma unroll
                for (int bj = 0; bj < 2; ++bj)
                    emit(brow + ai * HALF + wr * 64 + m * 16 + fr, bcol + bj * HALF + wc * 32 + fq * 8, acc[ai][bj][m][0], acc[ai][bj][m][1]);
        if (!has_next) break;
#pragma unroll
        for (int a = 0; a < 2; ++a)
#pragma unroll
            for (int b = 0; b < 2; ++b)
#pragma unroll
                for (int m = 0; m < 4; ++m)
#pragma unroll
                    for (int n = 0; n < 2; ++n) acc[a][b][m][n] = (f32x4){0.f, 0.f, 0.f, 0.f};
        brow = nrow; bcol = ncol; cA = nA; cB = nB; ++ui;
        if (NSTORE != 0 && wr == 1) G_BAR;
    }
    G_WAIT_V(0);
    if (NSTORE == 0 && wr == 0) G_BAR;
    G_BAR;
#undef G_SA
#undef G_SB
#undef G_STAGE
#undef G_LDA
#undef G_LDB
#undef G_MMA
}

DEVI void tile_map(int L, int nM, int nN, int& pm, int& pn) {
    const int nwg = nM * nN;
    int wgid = L;
    { const int q = nwg / 8, r = nwg % 8, xcd = wgid % 8, off = wgid / 8; wgid = (xcd < r ? xcd * (q + 1) : r * (q + 1) + (xcd - r) * q) + off; }
    const int nig = 8 * nN, gid = wgid / nig, fm = gid * 8, gsz = (nM - fm) < 8 ? (nM - fm) : 8;
    pm = fm + ((wgid % nig) % gsz); pn = (wgid % nig) / gsz;
}

template <int KW, class F>
DEVI void gemm_small(const bf16_t* __restrict__ A, int lda, const bf16_t* __restrict__ Bt, int ldb, int K, int row0, int col0, float* lds, F&& emit) {
    constexpr int RW = 8 / KW, MT16 = 4 / RW;
    const int tid = get_tid(), wv = tid >> 6, lane = tid & 63, fr = lane & 15, fq = lane >> 4;
    const int kq = wv % KW, rh = wv / KW;
    const int ks = K / KW, kbeg = kq * ks;
    f32x4 acc[MT16][4];
#pragma unroll
    for (int m = 0; m < MT16; ++m)
#pragma unroll
        for (int n = 0; n < 4; ++n) acc[m][n] = (f32x4){0.f, 0.f, 0.f, 0.f};
    const bf16_t* ap = A + (size_t)(row0 + rh * (64 / RW) + fr) * lda + kbeg + 8 * fq;
    const bf16_t* bp = Bt + (size_t)(col0 + 8 * (fr >> 2) + (fr & 3)) * ldb + kbeg + 8 * fq;
#pragma unroll 4
    for (int k = 0; k < ks; k += 32) {
        bf16x8 af[MT16], bfr[4];
#pragma unroll
        for (int m = 0; m < MT16; ++m) af[m] = *(const bf16x8*)(ap + (size_t)(m * 16) * lda + k);
#pragma unroll
        for (int n = 0; n < 4; ++n) bfr[n] = *(const bf16x8*)(bp + (size_t)((n >> 1) * 32 + (n & 1) * 4) * ldb + k);
#pragma unroll
        for (int m = 0; m < MT16; ++m)
#pragma unroll
            for (int n = 0; n < 4; ++n) acc[m][n] = __builtin_amdgcn_mfma_f32_16x16x32_bf16(bfr[n], af[m], acc[m][n], 0, 0, 0);
    }
    __syncthreads();
    float* slab = lds + kq * 4096;
#pragma unroll
    for (int m = 0; m < MT16; ++m)
#pragma unroll
        for (int n = 0; n < 4; ++n) {
            const int row = rh * (64 / RW) + m * 16 + fr, grp = ((n >> 1) * 8 + 2 * fq + (n & 1)) ^ (row & 15);
            *(f32x4*)(slab + row * 64 + grp * 4) = acc[m][n];
        }
    __syncthreads();
    {
        const int row = tid >> 3, c = tid & 7, g0 = c * 2, g1 = g0 + 1;
        f32x4 v0 = {0.f, 0.f, 0.f, 0.f}, v1 = {0.f, 0.f, 0.f, 0.f};
#pragma unroll
        for (int w = 0; w < KW; ++w) {
            v0 += *(const f32x4*)(lds + w * 4096 + row * 64 + ((g0 ^ (row & 15)) * 4));
            v1 += *(const f32x4*)(lds + w * 4096 + row * 64 + ((g1 ^ (row & 15)) * 4));
        }
        emit(row0 + row, col0 + g0 * 4, v0, v1);
    }
    __syncthreads();
}

DEVI void st_bf16x8(bf16_t* p, f32x4 a, f32x4 b) { u32x4 w; w.x = pk2(a[0], a[1]); w.y = pk2(a[2], a[3]); w.z = pk2(b[0], b[1]); w.w = pk2(b[2], b[3]); *(u32x4*)p = w; }

struct TJob { const float* src; bf16_t* dst; int K, N, Npad, src_ld; float scale; int scale_cols; const float* kgain; };
DEVI bool get_tjob(const Params& p, int j, TJob& t) {
    unsigned char* ws = p.ws;
    switch (j) {
    case 0: t = {p.in[11], (bf16_t*)(ws + WS_W1T), 1024, 3072, 3072, 3072, SBQ, 512, p.in[7]}; return true;
    case 1: t = {p.in[13], (bf16_t*)(ws + WS_WO1T), 1024, 1024, 1024, 1024, 1.f, 0, nullptr}; return true;
    case 2: t = {p.in[25], (bf16_t*)(ws + WS_WUP0), 1024, 4096, 4096, 4096, 1.f, 0, p.in[9]}; return true;
    case 3: t = {p.in[25] + 1024ull * 4096, (bf16_t*)(ws + WS_WUP1), 1024, 4096, 4096, 4096, 1.f, 0, p.in[9] + 1024}; return true;
    case 4: t = {p.in[26], (bf16_t*)(ws + WS_WDN0), 4096, 1024, 1024, 1024, 1.f, 0, nullptr}; return true;
    case 5: t = {p.in[26] + 1024ull * 4096, (bf16_t*)(ws + WS_WDN1), 4096, 1024, 1024, 1024, 1.f, 0, nullptr}; return true;
    case 6: t = {p.in[14], (bf16_t*)(ws + WS_W2T), 1024, 1696, 1792, 1696, 1.f, 0, p.in[7] + 1024}; return true;
    case 7: t = {p.in[21], (bf16_t*)(ws + WS_WUQT), 384, 768, 768, 768, MLQ, 768, nullptr}; return true;
    case 8: t = {p.in[24], (bf16_t*)(ws + WS_WO2T), 1024, 1024, 1024, 1024, 1.f, 0, nullptr}; return true;
    default:
        if (j < 17) { int h = j - 9; t = {p.in[23] + (size_t)h * 256 * 64, (bf16_t*)(ws + WS_WKVT) + (size_t)(512 + h * 64) * 256, 256, 64, 64, 64, 1.f, 0, nullptr}; return true; }
        return false;
    }
}

DEVI void phase_prep(const Params& p, float* lds) {
    const int tid = get_tid();
    int base = 0;
    for (int j = 0; j < 17; ++j) {
        TJob t; get_tjob(p, j, t);
        const int tk = t.K / 64, tn = t.Npad / 64, ntile = tk * tn;
        int first = ((int)blockIdx.x - base % (int)gridDim.x + (int)gridDim.x) % (int)gridDim.x;
        for (int i = first; i < ntile; i += gridDim.x) {
            const int k0 = (i % tk) * 64, n0 = (i / tk) * 64;
            __syncthreads();
#pragma unroll
            for (int e = 0; e < 2; ++e) {
                const int idx = tid + e * 512, kk = idx >> 4, n4 = (idx & 15) * 4, n = n0 + n4;
                f32x4 v = {0.f, 0.f, 0.f, 0.f};
                if (n < t.N) { v = *(const f32x4*)(t.src + (size_t)(k0 + kk) * t.src_ld + n); if (n < t.scale_cols) v = v * t.scale; if (t.kgain) v = v * t.kgain[k0 + kk]; }
                lds[kk * 65 + n4] = v[0]; lds[kk * 65 + n4 + 1] = v[1]; lds[kk * 65 + n4 + 2] = v[2]; lds[kk * 65 + n4 + 3] = v[3];
            }
            __syncthreads();
            {
                const int nn = tid >> 3, kc = tid & 7;
                float o[8];
#pragma unroll
                for (int j = 0; j < 8; ++j) o[j] = lds[(kc * 8 + j) * 65 + nn];
                *(u32x4*)(t.dst + (size_t)(n0 + nn) * t.K + k0 + kc * 8) = pack8(o);
            }
        }
        base += ntile;
    }
    const int gtid = blockIdx.x * 512 + tid, gsz = gridDim.x * 512;
    {
        bf16_t* dst = (bf16_t*)(p.ws + WS_WKVT);
        const float* src = p.in[22];
        for (int i = gtid; i < 512 * 256; i += gsz) dst[i] = f2bf(src[i]);
    }
    {
        bf16_t* dst = (bf16_t*)(p.ws + WS_WQLT);
        const float* wuq = p.in[21];
        const float* wuk = p.in[22];
        for (int i = gtid; i < 2048 * 384; i += gsz) {
            int c = i & 255, h = (i >> 8) & 7, j = i >> 11;
            const float* a = wuq + (size_t)j * 768 + h * 96;
            const float* b = wuk + (size_t)h * 64 * 256 + c;
            float s = 0.f;
#pragma unroll 8
            for (int n = 0; n < 64; ++n) s += a[n] * b[(size_t)n * 256];
            dst[(size_t)(h * 256 + c) * 384 + j] = f2bf(s * MLQ);
        }
    }
    {
        const int wv = tid >> 6, lane = tid & 63;
        bf16_t* X = (bf16_t*)(p.ws + WS_H);
        float* RS = (float*)(p.ws + WS_RS);
        for (int rowb = (blockIdx.x * 8 + wv) * 2; rowb < MT; rowb += gridDim.x * 16) {
            float v[2][16]; float ss[2] = {0.f, 0.f};
#pragma unroll
            for (int rr = 0; rr < 2; ++rr) {
                const int row = rowb + rr;
                const float* x = row < NP ? p.in[0] + (size_t)row * 1024 : p.in[1] + (size_t)(row - NP) * 1024;
#pragma unroll
                for (int i = 0; i < 2; ++i) {
                    f32x4 a = __builtin_nontemporal_load((const f32x4*)(x + i * 512 + lane * 8)), b = __builtin_nontemporal_load((const f32x4*)(x + i * 512 + lane * 8 + 4));
#pragma unroll
                    for (int k = 0; k < 4; ++k) { v[rr][i * 8 + k] = a[k]; v[rr][i * 8 + 4 + k] = b[k]; }
                }
            }
#pragma unroll
            for (int rr = 0; rr < 2; ++rr)
#pragma unroll
                for (int k = 0; k < 16; ++k) ss[rr] += v[rr][k] * v[rr][k];
#pragma unroll
            for (int of = 32; of > 0; of >>= 1) { ss[0] += __shfl_xor(ss[0], of); ss[1] += __shfl_xor(ss[1], of); }
#pragma unroll
            for (int rr = 0; rr < 2; ++rr) {
                const float r = rsqrtf(ss[rr] * (1.f / 1024.f) + EPS);
#pragma unroll
                for (int k = 0; k < 16; ++k) v[rr][k] *= r;
#pragma unroll
                for (int i = 0; i < 2; ++i) *(u32x4*)(X + (size_t)(rowb + rr) * 1024 + i * 512 + lane * 8) = pack8(v[rr] + i * 8);
                if (lane == 0) RS[rowb + rr] = r;
            }
        }
    }
}

DEVI void phase_rowpass(const Params& p, bool first, const float* g1, bool final_) {
    const int tid = get_tid(), wv = tid >> 6, lane = tid & 63;
    const bf16_t* O = (const bf16_t*)(p.ws + WS_O);
    bf16_t* X = (bf16_t*)(p.ws + WS_H);
    float* RS = (float*)(p.ws + WS_RS);
    float ga[16];
#pragma unroll
    for (int i = 0; i < 2; ++i)
#pragma unroll
        for (int k = 0; k < 8; ++k) ga[i * 8 + k] = g1[i * 512 + lane * 8 + k];
    for (int rowb = (blockIdx.x * 8 + wv) * 2; rowb < MT; rowb += gridDim.x * 16) {
        float o[2][16], x[2][16];
#pragma unroll
        for (int rr = 0; rr < 2; ++rr) {
            const int row = rowb + rr;
#pragma unroll
            for (int i = 0; i < 2; ++i) {
                unpack8(*(const u32x4*)(O + (size_t)row * 1024 + i * 512 + lane * 8), o[rr] + i * 8);
                if (first) {
                    const float* xin = row < NP ? p.in[0] + (size_t)row * 1024 : p.in[1] + (size_t)(row - NP) * 1024;
                    f32x4 a = *(const f32x4*)(xin + i * 512 + lane * 8), b = *(const f32x4*)(xin + i * 512 + lane * 8 + 4);
#pragma unroll
                    for (int k = 0; k < 4; ++k) { x[rr][i * 8 + k] = a[k]; x[rr][i * 8 + 4 + k] = b[k]; }
                } else unpack8(*(const u32x4*)(X + (size_t)row * 1024 + i * 512 + lane * 8), x[rr] + i * 8);
            }
            if (!first) {
                const float inv = 1.f / RS[row];
#pragma unroll
                for (int k = 0; k < 16; ++k) x[rr][k] *= inv;
            }
        }
        float ss[2] = {0.f, 0.f};
#pragma unroll
        for (int rr = 0; rr < 2; ++rr)
#pragma unroll
            for (int k = 0; k < 16; ++k) ss[rr] += o[rr][k] * o[rr][k];
#pragma unroll
        for (int of = 32; of > 0; of >>= 1) { ss[0] += __shfl_xor(ss[0], of); ss[1] += __shfl_xor(ss[1], of); }
        float s2[2] = {0.f, 0.f};
#pragma unroll
        for (int rr = 0; rr < 2; ++rr) {
            const float r = rsqrtf(ss[rr] * (1.f / 1024.f) + EPS);
#pragma unroll
            for (int k = 0; k < 16; ++k) { float v = x[rr][k] + o[rr][k] * r * ga[k]; x[rr][k] = v; s2[rr] += v * v; }
        }
        if (final_) {
#pragma unroll
            for (int rr = 0; rr < 2; ++rr) {
                float* y = p.out + O_Y + (size_t)(rowb + rr) * 1024;
#pragma unroll
                for (int i = 0; i < 2; ++i) {
                    *(f32x4*)(y + i * 512 + lane * 8) = (f32x4){x[rr][i * 8], x[rr][i * 8 + 1], x[rr][i * 8 + 2], x[rr][i * 8 + 3]};
                    *(f32x4*)(y + i * 512 + lane * 8 + 4) = (f32x4){x[rr][i * 8 + 4], x[rr][i * 8 + 5], x[rr][i * 8 + 6], x[rr][i * 8 + 7]};
                }
            }
        } else {
#pragma unroll
            for (int of = 32; of > 0; of >>= 1) { s2[0] += __shfl_xor(s2[0], of); s2[1] += __shfl_xor(s2[1], of); }
#pragma unroll
            for (int rr = 0; rr < 2; ++rr) {
                const float r2 = rsqrtf(s2[rr] * (1.f / 1024.f) + EPS);
#pragma unroll
                for (int k = 0; k < 16; ++k) x[rr][k] *= r2;
#pragma unroll
                for (int i = 0; i < 2; ++i) *(u32x4*)(X + (size_t)(rowb + rr) * 1024 + i * 512 + lane * 8) = pack8(x[rr] + i * 8);
                if (lane == 0) RS[rowb + rr] = r2;
            }
        }
    }
}

DEVI void rope_consts(int i, float& crev) { crev = __builtin_amdgcn_exp2f(-(float)i * (13.287712379549449f / 16.f)) * 0.15915494309189535f; }
DEVI void rope_sc(int pos, float crev, float& s, float& c) { float rev = (float)pos * crev; rev -= floorf(rev); s = __builtin_amdgcn_sinf(rev); c = __builtin_amdgcn_cosf(rev); }

DEVI void phase_l1rows(const Params& p) {
    const int tid = get_tid(), wv = tid >> 6, lane = tid & 63;
    bf16_t* IN1 = (bf16_t*)(p.ws + WS_R1 + R1_IN1);
    bf16_t* KC = (bf16_t*)(p.ws + WS_KC);
    const float* lng = p.in[15]; const float* lnb = p.in[16]; const float* qg = p.in[19]; const float* kvg = p.in[20];
    float crev; rope_consts(lane & 15, crev);
    float glng[8], glnb[8], gq[8], gkv[8];
#pragma unroll
    for (int k = 0; k < 8; ++k) { glng[k] = lng[lane * 8 + k]; glnb[k] = lnb[lane * 8 + k]; gq[k] = lane < 48 ? qg[lane * 8 + k] : 0.f; gkv[k] = lane < 32 ? kvg[lane * 8 + k] : 0.f; }
    for (int rowb = (blockIdx.x * 8 + wv) * 2; rowb < MT; rowb += gridDim.x * 16) {
        float v[2][8], cq[2][8], kv[2][8], x1[2], x2[2];
#pragma unroll
        for (int rr = 0; rr < 2; ++rr) {
            const bf16_t* r = IN1 + (size_t)(rowb + rr) * 1792;
            unpack8(*(const u32x4*)(r + 512 + lane * 8), v[rr]);
            u32x4 z = {0u, 0u, 0u, 0u};
            unpack8(lane < 48 ? *(const u32x4*)(r + 1024 + lane * 8) : z, cq[rr]);
            unpack8(lane < 32 ? *(const u32x4*)(r + 1408 + lane * 8) : z, kv[rr]);
            x1[rr] = lane < 16 ? bf2f(r[1664 + lane]) : 0.f; x2[rr] = lane < 16 ? bf2f(r[1680 + lane]) : 0.f;
        }
        float sv[2], sq[2], sk[2];
#pragma unroll
        for (int rr = 0; rr < 2; ++rr) {
            sv[rr] = 0.f; sq[rr] = 0.f; sk[rr] = 0.f;
#pragma unroll
            for (int k = 0; k < 8; ++k) { sv[rr] += v[rr][k]; sq[rr] += cq[rr][k] * cq[rr][k]; sk[rr] += kv[rr][k] * kv[rr][k]; }
        }
#pragma unroll
        for (int of = 32; of > 0; of >>= 1)
#pragma unroll
            for (int rr = 0; rr < 2; ++rr) { sv[rr] += __shfl_xor(sv[rr], of); sq[rr] += __shfl_xor(sq[rr], of); sk[rr] += __shfl_xor(sk[rr], of); }
        float var[2];
#pragma unroll
        for (int rr = 0; rr < 2; ++rr) {
            const float mu = sv[rr] * (1.f / 512.f); var[rr] = 0.f;
#pragma unroll
            for (int k = 0; k < 8; ++k) { v[rr][k] -= mu; var[rr] += v[rr][k] * v[rr][k]; }
        }
#pragma unroll
        for (int of = 32; of > 0; of >>= 1) { var[0] += __shfl_xor(var[0], of); var[1] += __shfl_xor(var[1], of); }
#pragma unroll
        for (int rr = 0; rr < 2; ++rr) {
            const int row = rowb + rr;
            bf16_t* r = IN1 + (size_t)row * 1792;
            {
                const float rs = rsqrtf(var[rr] * (1.f / 512.f) + EPS);
#pragma unroll
                for (int k = 0; k < 8; ++k) v[rr][k] = v[rr][k] * rs * glng[k] + glnb[k];
                *(u32x4*)(r + 512 + lane * 8) = pack8(v[rr]);
                if (row >= NP) {
                    float* o = p.out + O_SGUV_S + (size_t)(row - NP) * 512 + lane * 8;
                    *(f32x4*)o = (f32x4){v[rr][0], v[rr][1], v[rr][2], v[rr][3]}; *(f32x4*)(o + 4) = (f32x4){v[rr][4], v[rr][5], v[rr][6], v[rr][7]};
                }
            }
            if (lane < 48) {
                const float rs = rsqrtf(sq[rr] * (1.f / 384.f) + EPS);
#pragma unroll
                for (int k = 0; k < 8; ++k) cq[rr][k] = cq[rr][k] * rs * gq[k];
                *(u32x4*)(r + 1024 + lane * 8) = pack8(cq[rr]);
            }
            if (lane < 32) {
                const float rs = rsqrtf(sk[rr] * (1.f / 256.f) + EPS);
#pragma unroll
                for (int k = 0; k < 8; ++k) kv[rr][k] = kv[rr][k] * rs * gkv[k];
                u32x4 w = pack8(kv[rr]);
                *(u32x4*)(r + 1408 + lane * 8) = w;
                float* o = row < NP ? p.out + O_CKV_P + (size_t)row * 256 + lane * 8 : p.out + O_CKV_S + (size_t)(row - NP) * 256 + lane * 8;
                *(f32x4*)o = (f32x4){kv[rr][0], kv[rr][1], kv[rr][2], kv[rr][3]}; *(f32x4*)(o + 4) = (f32x4){kv[rr][4], kv[rr][5], kv[rr][6], kv[rr][7]};
                if (row >= NP) { int b = (row - NP) >> 4, t = (row - NP) & 15; *(u32x4*)(KC + ((size_t)b * 4112 + 4096 + t) * 288 + lane * 8) = w; }
            }
            if (lane < 16) {
                float sn, c; rope_sc(row_pos(row), crev, sn, c);
                float o1 = x1[rr] * c - x2[rr] * sn, o2 = x1[rr] * sn + x2[rr] * c;
                bf16_t b1 = f2bf(o1), b2 = f2bf(o2);
                r[1664 + lane] = b1; r[1680 + lane] = b2;
                float* o = row < NP ? p.out + O_KPE_P + (size_t)row * 32 : p.out + O_KPE_S + (size_t)(row - NP) * 32;
                o[lane] = o1; o[lane + 16] = o2;
                if (row >= NP) { int b = (row - NP) >> 4, t = (row - NP) & 15; bf16_t* kc = KC + ((size_t)b * 4112 + 4096 + t) * 288 + 256; kc[lane] = b1; kc[lane + 16] = b2; }
            }
        }
    }
}

DEVI void kc_item(const Params& p, int item) {
    const int tid = get_tid();
    bf16_t* KC = (bf16_t*)(p.ws + WS_KC);
    const float* cc = p.in[5]; const float* cp = p.in[6];
#pragma unroll
    for (int e = 0; e < 8; ++e) {
        const long id = (long)item * 4096 + e * 512 + tid;
        const long rw = id / 36; const int ch = (int)(id - rw * 36);
        const int b = (int)(rw >> 12), kk = (int)(rw & 4095);
        const float* src = ch < 32 ? cc + (size_t)rw * 256 + ch * 8 : cp + (size_t)rw * 32 + (ch - 32) * 8;
        f32x4 a = *(const f32x4*)src, bb = *(const f32x4*)(src + 4);
        u32x4 w; w.x = pk2(a[0], a[1]); w.y = pk2(a[2], a[3]); w.z = pk2(bb[0], bb[1]); w.w = pk2(bb[2], bb[3]);
        *(u32x4*)(KC + ((size_t)b * 4112 + kk) * 288 + ch * 8) = w;
    }
}

DEVI void conv_item(const Params& p, int item) {
    const int tid = get_tid(), ch = tid & 63, rs = tid >> 6;
    const bf16_t* Q = (const bf16_t*)(p.ws + WS_R1 + R1_QKVG);
    bf16_t* MX = (bf16_t*)(p.ws + WS_R1 + R1_MIXED);
    const float* wc = p.in[12];
    float w0[8], w1[8], w2[8];
#pragma unroll
    for (int k = 0; k < 8; ++k) { w0[k] = wc[ch * 8 + k]; w1[k] = wc[512 + ch * 8 + k]; w2[k] = wc[1024 + ch * 8 + k]; }
#pragma unroll 1
    for (int i = 0; i < 4; ++i) {
        int rbase = item * 32;
        if (item < 2048) { const int bi = item >> 6; rbase = ((bi & 7) * 4 + (3 - (bi >> 3))) * 2048 + (item & 63) * 32; }
        const int row = rbase + rs + i * 8;
        const bool samp = row >= NP;
        const int t = samp ? (row - NP) & 15 : row & 2047;
        const int b = samp ? (row - NP) >> 4 : row >> 11;
        float cin[3][8];
#pragma unroll
        for (int j = 0; j < 3; ++j) {
            if (t - j >= 0) {
                const bf16_t* rr = Q + (size_t)(row - j) * 3072;
                float a[8], u[8]; unpack8(*(const u32x4*)(rr + 2048 + ch * 8), a); unpack8(*(const u32x4*)(rr + 2560 + ch * 8), u);
#pragma unroll
                for (int k = 0; k < 8; ++k) cin[j][k] = a[k] * u[k];
            } else if (samp) {
                const float* pv = p.in[4] + ((size_t)b * 2 + (2 + t - j)) * 512 + ch * 8;
#pragma unroll
                for (int k = 0; k < 8; ++k) cin[j][k] = pv[k];
            } else {
#pragma unroll
                for (int k = 0; k < 8; ++k) cin[j][k] = 0.f;
            }
        }
        {
            float kf[8], vf[8];
            unpack8(*(const u32x4*)(Q + (size_t)row * 3072 + 512 + ch * 8), kf); unpack8(*(const u32x4*)(Q + (size_t)row * 3072 + 1024 + ch * 8), vf);
            float* ok = p.out + (samp ? O_SBK_S + (size_t)(row - NP) * 512 : O_SBK_P + (size_t)row * 512) + ch * 8;
            float* ov = p.out + (samp ? O_SBV_S + (size_t)(row - NP) * 512 : O_SBV_P + (size_t)row * 512) + ch * 8;
            *(f32x4*)ok = (f32x4){kf[0], kf[1], kf[2], kf[3]}; *(f32x4*)(ok + 4) = (f32x4){kf[4], kf[5], kf[6], kf[7]};
            *(f32x4*)ov = (f32x4){vf[0], vf[1], vf[2], vf[3]}; *(f32x4*)(ov + 4) = (f32x4){vf[4], vf[5], vf[6], vf[7]};
        }
        float gp[8]; unpack8(*(const u32x4*)(Q + (size_t)row * 3072 + 1536 + ch * 8), gp);
        float o[8];
#pragma unroll
        for (int k = 0; k < 8; ++k) o[k] = gp[k] * (w0[k] * cin[2][k] + w1[k] * cin[1][k] + w2[k] * cin[0][k]);
        *(u32x4*)(MX + (size_t)row * 1024 + 512 + ch * 8) = pack8(o);
        const int tl = samp ? 14 : 2046;
        if (t >= tl) {
            float* o2 = p.out + (samp ? O_CONV_S : O_CONV_P) + ((size_t)b * 2 + (t - tl)) * 512 + ch * 8;
#pragma unroll
            for (int k = 0; k < 8; ++k) o2[k] = cin[0][k];
        }
    }
}

DEVI s4v tr_read(const unsigned char* lp) { return __builtin_amdgcn_ds_read_tr16_b64_v4i16((__attribute__((address_space(3))) s4v*)(lp)); }

DEVI void sgu_item(const Params& p, int sg, unsigned char* smem) {
    const int tid = get_tid(), wv = tid >> 6, lane = tid & 63;
    int g, row0, L;
    if (sg < 2048) { const int chunk = sg >> 2; g = sg & 3; row0 = (chunk >> 4) * 2048 + (chunk & 15) * 128; L = 128; }
    else { const int s2 = sg - 2048; g = s2 & 3; row0 = NP + (s2 >> 2) * 16; L = 16; }
    bf16_t* IN1 = (bf16_t*)(p.ws + WS_R1 + R1_IN1);
    bf16_t* MX = (bf16_t*)(p.ws + WS_R1 + R1_MIXED2);
    const float* Wg = p.in[17] + (size_t)g * 128 * 128;
    const float* bs = p.in[18] + g * 128;
    constexpr int STR = 272;
    unsigned char* Wl = smem; unsigned char* Vl = smem + 128 * STR;
#pragma unroll
    for (int e = 0; e < 8; ++e) {
        int idx = tid + e * 512, t = idx >> 5, s4 = (idx & 31) * 4;
        f32x4 w = {0.f, 0.f, 0.f, 0.f};
        if (t < L) w = *(const f32x4*)(Wg + t * 128 + s4);
        float o[4];
#pragma unroll
        for (int k = 0; k < 4; ++k) o[k] = (s4 + k <= t && s4 + k < L) ? w[k] : 0.f;
        u32x2 pw; pw.x = pk2(o[0], o[1]); pw.y = pk2(o[2], o[3]);
        *(u32x2*)(Wl + t * STR + s4 * 2) = pw;
    }
#pragma unroll
    for (int e = 0; e < 4; ++e) {
        int idx = tid + e * 512, s = idx >> 4, c = idx & 15;
        u32x4 w = {0u, 0u, 0u, 0u};
        if (s < L) w = *(const u32x4*)(IN1 + (size_t)(row0 + s) * 1792 + 512 + g * 128 + c * 8);
        *(u32x4*)(Vl + s * STR + c * 16) = w;
    }
    __syncthreads();
    const int tb = wv >> 1, r = lane & 31, h = lane >> 5, grp = lane >> 4, q = (lane & 15) >> 2, pp = lane & 3;
    f32x16 acc[2] = {};
    if (tb * 32 < L) {
        for (int sb = 0; sb <= tb; ++sb) {
#pragma unroll
            for (int st = 0; st < 2; ++st) {
                bf16x8 a = *(const bf16x8*)(Wl + (tb * 32 + r) * STR + (sb * 32 + st * 16 + 8 * h) * 2);
#pragma unroll
                for (int d2 = 0; d2 < 2; ++d2) {
                    const int db = (wv & 1) * 2 + d2;
                    const unsigned char* vp = Vl + (sb * 32 + st * 16 + 8 * h + q) * STR + (db * 32 + 16 * (grp & 1) + 4 * pp) * 2;
                    s4v lo = tr_read(vp), hi = tr_read(vp + 4 * STR);
                    bf16x8 bfr = __builtin_shufflevector(lo, hi, 0, 1, 2, 3, 4, 5, 6, 7);
                    acc[d2] = __builtin_amdgcn_mfma_f32_32x32x16_bf16(a, bfr, acc[d2], 0, 0, 0);
                }
            }
        }
    }
    __syncthreads();
    float* Sl = (float*)smem;
    if (tb * 32 < L) {
#pragma unroll
        for (int d2 = 0; d2 < 2; ++d2) {
            const int d = ((wv & 1) * 2 + d2) * 32 + r;
#pragma unroll
            for (int reg = 0; reg < 16; ++reg) {
                const int t = tb * 32 + (reg & 3) + 8 * (reg >> 2) + 4 * h;
                Sl[t * 132 + d] = acc[d2][reg];
            }
        }
    }
    __syncthreads();
#pragma unroll
    for (int e = 0; e < 4; ++e) {
        const int idx = tid + e * 512, t = idx >> 4, c = idx & 15;
        if (t < L) {
            float u[8]; unpack8(*(const u32x4*)(IN1 + (size_t)(row0 + t) * 1792 + g * 128 + c * 8), u);
            const f32x4 s0 = *(const f32x4*)(Sl + t * 132 + c * 8), s1 = *(const f32x4*)(Sl + t * 132 + c * 8 + 4);
            const float bt = bs[t];
            float o[8];
#pragma unroll
            for (int k = 0; k < 4; ++k) { o[k] = u[k] * (s0[k] + bt); o[4 + k] = u[4 + k] * (s1[k] + bt); }
            *(u32x4*)(MX + (size_t)(row0 + t) * 1024 + g * 128 + c * 8) = pack8(o);
        }
    }
}

template <int MODE> struct AC;
template <> struct AC<0> { static constexpr int DQK = 64, DV = 64, KSTR = 144, VSTR = 144, NST = 2; };
template <> struct AC<1> { static constexpr int DQK = 96, DV = 64, KSTR = 208, VSTR = 192, NST = 3; };
template <> struct AC<2> { static constexpr int DQK = 288, DV = 256, KSTR = 592, VSTR = 592, NST = 5; };
constexpr int SM_V = 40960, SM_FLAG = 65536;

DEVI u32x4 ld_f32x8_bf16(const float* src) {
    f32x4 a = *(const f32x4*)src, b = *(const f32x4*)(src + 4);
    u32x4 w; w.x = pk2(a[0], a[1]); w.y = pk2(a[2], a[3]); w.z = pk2(b[0], b[1]); w.w = pk2(b[2], b[3]); return w;
}

template <int MODE>
DEVI void attn_item(const Params& p, int item, unsigned char* smem) {
    typedef AC<MODE> C;
    constexpr int KS = C::DQK / 16, DB = (MODE == 2) ? 4 : C::DV / 32, NST = C::NST, NQF = (MODE == 2) ? 1 : KS;
    const int tid = get_tid(), wv = tid >> 6, lane = tid & 63;
    const int r = lane & 31, h = lane >> 5, grp = lane >> 4, q4 = (lane & 15) >> 2, pp = lane & 3;
    unsigned char* Ks = smem;
    unsigned char* Vs = (MODE == 2) ? smem : smem + SM_V;
    unsigned char* Qs = smem + SM_V;
    volatile int* flags = (volatile int*)(smem + SM_FLAG);

    int b = 0, hd = 0, q0 = 0, kt_last = 0; bool samp = false;
    if constexpr (MODE == 0) {
        if (item < 2048) { const int bi = item >> 6, qb = 7 - ((item >> 3) & 7); b = (bi & 7) * 4 + (3 - (bi >> 3)); hd = item & 7; q0 = qb * 256; kt_last = (q0 + 255) >> 6; }
        else { const int s = item - 2048; b = s >> 3; hd = s & 7; samp = true; q0 = 4096; kt_last = 64; }
    } else if constexpr (MODE == 1) {
        const int qb = 7 - (item >> 8); b = (item & 255) >> 3; hd = item & 7; q0 = qb * 256; kt_last = (q0 + 255) >> 6;
    } else { b = item; kt_last = 64; }
    const bf16_t* QKVG = (const bf16_t*)(p.ws + WS_R1 + R1_QKVG);
    const bf16_t* IN1 = (const bf16_t*)(p.ws + WS_R1 + R1_IN1);
    const bf16_t* QF = (const bf16_t*)(p.ws + WS_R1 + R1_QF);
    const bf16_t* KVUP = (const bf16_t*)(p.ws + WS_R1 + R1_KVUP);
    const bf16_t* QLAT = (const bf16_t*)(p.ws + WS_R1 + R1_QLAT);
    const bf16_t* KC = (const bf16_t*)(p.ws + WS_KC);

    bool wactive; int qpos = 0; bool qvalid = true; size_t orow = 0;
    bf16x8 qf[NQF];
    const int rg = wv & 3, dvh = (MODE == 2) ? (wv >> 2) : 0;
    if constexpr (MODE == 0) {
        wactive = samp ? (wv == 0) : true;
        int qi = samp ? (r & 15) : (wv * 32 + r);
        qvalid = samp ? (r < 16) : true;
        qpos = q0 + qi;
        orow = samp ? (size_t)(NP + b * 16 + qi) : (size_t)(b * 2048 + q0 + qi);
        const bf16_t* qp = QKVG + orow * 3072 + hd * 64;
#pragma unroll
        for (int st = 0; st < KS; ++st) qf[st] = *(const bf16x8*)(qp + st * 16 + 8 * h);
    } else if constexpr (MODE == 1) {
        wactive = true; qpos = q0 + wv * 32 + r; orow = (size_t)(b * 2048 + qpos);
        const bf16_t* qp = QF + orow * 768 + hd * 96;
#pragma unroll
        for (int st = 0; st < KS; ++st) qf[st] = *(const bf16x8*)(qp + st * 16 + 8 * h);
#pragma unroll
        for (int j = 0; j < 8; ++j) {
            float crev; rope_consts(8 * h + j, crev);
            float sn, cs; rope_sc(qpos, crev, sn, cs);
            const float x1 = bf2f((unsigned short)qf[4][j]), x2 = bf2f((unsigned short)qf[5][j]);
            qf[4][j] = (short)f2bf(x1 * cs - x2 * sn); qf[5][j] = (short)f2bf(x1 * sn + x2 * cs);
        }
    } else {
        wactive = true;
        for (int id = tid; id < 128 * 36; id += 512) {
            const int rr = id / 36, ch = id % 36, hh = rr >> 4, t = rr & 15;
            u32x4 w = ch < 32 ? *(const u32x4*)(QLAT + (size_t)(b * 16 + t) * 2048 + hh * 256 + ch * 8)
                              : *(const u32x4*)(QF + (size_t)(NP + b * 16 + t) * 768 + hh * 96 + 64 + (ch - 32) * 8);
            *(u32x4*)(Qs + rr * 592 + ch * 16) = w;
        }
        __syncthreads();
        for (int id = tid; id < 128 * 16; id += 512) {
            const int rr = id >> 4, i = id & 15, t = rr & 15;
            bf16_t* qrow = (bf16_t*)(Qs + rr * 592);
            float crev; rope_consts(i, crev);
            float sn, cs; rope_sc(4096 + t, crev, sn, cs);
            const float x1 = bf2f(qrow[256 + i]), x2 = bf2f(qrow[272 + i]);
            qrow[256 + i] = f2bf(x1 * cs - x2 * sn); qrow[272 + i] = f2bf(x1 * sn + x2 * cs);
        }
    }
    const int wave_qmax = q0 + wv * 32 + 31;
    const int wave_chunk = (q0 + wv * 32) >> 6;

    f32x16 O[DB];
#pragma unroll
    for (int d = 0; d < DB; ++d) O[d] = (f32x16){};
    float carry = (MODE == 0) ? 1.f : 0.f, mrun = -INFINITY, lrun = 0.f;

    constexpr int NH = (MODE == 2) ? 1 : 2;
    u32x4 stg[NH][NST];
    auto issue = [&](int kT) {
#pragma unroll
        for (int hf = 0; hf < NH; ++hf) {
            const int kt = kT * NH + hf;
#pragma unroll
            for (int i = 0; i < NST; ++i) {
                u32x4 w = {0u, 0u, 0u, 0u};
                if constexpr (MODE == 0) {
                    const int row = tid >> 3, ch = tid & 7, kk = kt * 64 + row;
                    const int off = (i == 0 ? 512 : 1024) + hd * 64 + ch * 8;
                    if (!samp) w = *(const u32x4*)(QKVG + (size_t)(b * 2048 + kk) * 3072 + off);
                    else if (kk < 4096) w = ld_f32x8_bf16(p.in[i == 0 ? 2 : 3] + (((size_t)b * 4096 + kk) * 8 + hd) * 64 + ch * 8);
                    else if (kk < 4112) w = *(const u32x4*)(QKVG + (size_t)(NP + b * 16 + kk - 4096) * 3072 + off);
                } else if constexpr (MODE == 1) {
                    if (i == 0) { const int row = tid >> 3, ch = tid & 7; w = *(const u32x4*)(KVUP + (size_t)(b * 2048 + kt * 64 + row) * 1024 + 512 + hd * 64 + ch * 8); }
                    else {
                        const int id = tid + (i - 1) * 512;
                        if (id < 768) { const int row = id / 12, ch = id % 12; const size_t gr = (size_t)(b * 2048 + kt * 64 + row);
                            w = ch < 8 ? *(const u32x4*)(KVUP + gr * 1024 + hd * 64 + ch * 8) : *(const u32x4*)(IN1 + gr * 1792 + 1664 + (ch - 8) * 8); }
                    }
                } else {
                    const int id = tid + i * 512;
                    if (id < 2304) { const int row = id / 36, ch = id % 36, kk = kt * 64 + row;
                        if (kk < 4112) w = *(const u32x4*)(KC + ((size_t)b * 4112 + kk) * 288 + ch * 8); }
                }
                stg[hf][i] = w;
            }
        }
    };
    auto commit = [&]() {
#pragma unroll
        for (int hf = 0; hf < NH; ++hf) {
            unsigned char* Kh = Ks + hf * 64 * C::KSTR; unsigned char* Vh = Vs + hf * 64 * C::VSTR;
#pragma unroll
            for (int i = 0; i < NST; ++i) {
                if constexpr (MODE == 0) { const int row = tid >> 3, ch = tid & 7; *(u32x4*)((i == 0 ? Kh + row * C::KSTR : Vh + row * C::VSTR) + ch * 16) = stg[hf][i]; }
                else if constexpr (MODE == 1) {
                    if (i == 0) { const int row = tid >> 3, ch = tid & 7; *(u32x4*)(Vh + row * C::VSTR + ch * 16) = stg[hf][0]; }
                    else { const int id = tid + (i - 1) * 512; if (id < 768) { const int row = id / 12, ch = id % 12; *(u32x4*)(Kh + row * C::KSTR + ch * 16) = stg[hf][i]; } }
                } else { const int id = tid + i * 512; if (id < 2304) { const int row = id / 36, ch = id % 36; *(u32x4*)(Kh + row * C::KSTR + ch * 16) = stg[hf][i]; } }
            }
        }
    };

    const int kT_last = kt_last / NH;
    issue(kT_last);
    int done = wactive ? 0 : 1, par = 0;
    for (int kT = kT_last; kT >= 0; --kT) {
        if constexpr (MODE == 0) { if (lane == 0) flags[par * 8 + wv] = done; }
        __syncthreads();
        if constexpr (MODE == 0) {
            int all = 1;
#pragma unroll
            for (int w = 0; w < 8; ++w) all &= flags[par * 8 + w];
            par ^= 1;
            if (all) break;
        }
        commit();
        __syncthreads();
        if (kT > 0) issue(kT - 1);
      f32x16 SA[NH][2]; bool relq[NH];
#pragma unroll
      for (int hfi = 0; hfi < NH; ++hfi) {
        const int hf = NH - 1 - hfi, kt = kT * NH + hf;
        unsigned char* Ks = smem + hf * 64 * C::KSTR;
        bool rel = wactive && (kt <= kt_last);
        if constexpr (MODE == 0) rel = rel && !done && (samp || kt * 64 < wave_qmax);
        if constexpr (MODE == 1) rel = rel && (kt <= wave_chunk);
        relq[hf] = rel;
        SA[hf][0] = (f32x16){}; SA[hf][1] = (f32x16){};
        if (rel) {
                constexpr int CH = (KS % 6 == 0) ? 6 : 4;
#pragma unroll
                for (int c0 = 0; c0 < KS; c0 += CH) {
                    bf16x8 ka[2][CH], qb[CH];
#pragma unroll
                    for (int s = 0; s < CH; ++s) {
                        ka[0][s] = *(const bf16x8*)(Ks + (r) * C::KSTR + ((c0 + s) * 16 + 8 * h) * 2);
                        ka[1][s] = *(const bf16x8*)(Ks + (32 + r) * C::KSTR + ((c0 + s) * 16 + 8 * h) * 2);
                        if constexpr (MODE == 2) qb[s] = *(const bf16x8*)(Qs + (rg * 32 + r) * 592 + ((c0 + s) * 16 + 8 * h) * 2); else qb[s] = qf[c0 + s];
                    }
                    __builtin_amdgcn_sched_barrier(0);
#pragma unroll
                    for (int s = 0; s < CH; ++s) {
                        SA[hf][0] = __builtin_amdgcn_mfma_f32_32x32x16_bf16(ka[0][s], qb[s], SA[hf][0], 0, 0, 0);
                        SA[hf][1] = __builtin_amdgcn_mfma_f32_32x32x16_bf16(ka[1][s], qb[s], SA[hf][1], 0, 0, 0);
                    }
                }
        }
      }
#pragma unroll
      for (int hfi = 0; hfi < NH; ++hfi) {
        const int hf = NH - 1 - hfi, kt = kT * NH + hf;
        unsigned char* Vs = ((MODE == 2) ? smem : smem + SM_V) + hf * 64 * C::VSTR;
        bool rel = relq[hf];
        if constexpr (MODE == 0) rel = rel && !done;
        if (rel) {
            f32x16 (&S)[2] = SA[hf];
            bf16x8 pf[2][2];
            if constexpr (MODE == 0) {
#pragma unroll
                for (int kbi = 0; kbi < 2; ++kbi) {
                    const int kb = 1 - kbi;
                    float bt[16], qv[16];
#pragma unroll
                    for (int reg = 0; reg < 16; ++reg) {
                        const int kk = kt * 64 + kb * 32 + (reg & 3) + 8 * (reg >> 2) + 4 * h;
                        const bool v = qvalid && (kk < qpos);
                        const float t = __builtin_amdgcn_exp2f(fminf(S[kb][reg], 120.f));
                        const float q = __builtin_amdgcn_rcpf(1.f + t);
                        bt[reg] = v ? t * q : 0.f; qv[reg] = v ? q : 1.f;
                    }
                    float G[4], PG[4], T[4];
#pragma unroll
                    for (int g = 0; g < 4; ++g) { G[g] = (qv[4 * g] * qv[4 * g + 1]) * (qv[4 * g + 2] * qv[4 * g + 3]); PG[g] = __shfl_xor(G[g], 32); }
                    T[3] = 1.f; T[2] = G[3] * PG[3]; T[1] = T[2] * (G[2] * PG[2]); T[0] = T[1] * (G[1] * PG[1]);
                    const float total = T[0] * (G[0] * PG[0]);
                    float w[16];
#pragma unroll
                    for (int g = 0; g < 4; ++g) {
                        float run = carry * T[g] * (h == 0 ? PG[g] : 1.f);
#pragma unroll
                        for (int i = 3; i >= 0; --i) {
                            const int reg = 4 * g + i;
                            w[reg] = bt[reg] * run;
                            run *= qv[reg];
                        }
                    }
                    carry *= total;
#pragma unroll
                    for (int s = 0; s < 2; ++s) {
                        u32x4 u; u.x = pk2(w[8 * s], w[8 * s + 1]); u.y = pk2(w[8 * s + 2], w[8 * s + 3]); u.z = pk2(w[8 * s + 4], w[8 * s + 5]); u.w = pk2(w[8 * s + 6], w[8 * s + 7]);
                        pf[kb][s] = __builtin_bit_cast(bf16x8, u);
                    }
                }
                done = __all((!qvalid) || (carry < 1e-36f)) ? 1 : 0;
            } else {
                float mx = -INFINITY;
#pragma unroll
                for (int kb = 0; kb < 2; ++kb)
#pragma unroll
                    for (int reg = 0; reg < 16; ++reg) {
                        if constexpr (MODE == 2) { const int kk = kt * 64 + kb * 32 + (reg & 3) + 8 * (reg >> 2) + 4 * h; if (kk >= 4112) S[kb][reg] = -INFINITY; }
                        mx = fmaxf(mx, S[kb][reg]);
                    }
                mx = fmaxf(mx, __shfl_xor(mx, 32));
                const float mn = fmaxf(mrun, mx);
                const float alpha = __builtin_amdgcn_exp2f(mrun - mn);
                mrun = mn;
                float ls = 0.f;
#pragma unroll
                for (int kb = 0; kb < 2; ++kb) {
                    float w[16];
#pragma unroll
                    for (int reg = 0; reg < 16; ++reg) { w[reg] = __builtin_amdgcn_exp2f(S[kb][reg] - mn); ls += w[reg]; }
#pragma unroll
                    for (int s = 0; s < 2; ++s) {
                        u32x4 u; u.x = pk2(w[8 * s], w[8 * s + 1]); u.y = pk2(w[8 * s + 2], w[8 * s + 3]); u.z = pk2(w[8 * s + 4], w[8 * s + 5]); u.w = pk2(w[8 * s + 6], w[8 * s + 7]);
                        pf[kb][s] = __builtin_bit_cast(bf16x8, u);
                    }
                }
                lrun = lrun * alpha + ls;
                if (!__all(alpha == 1.f)) {
#pragma unroll
                    for (int d = 0; d < DB; ++d) O[d] = O[d] * alpha;
                }
            }
#pragma unroll
            for (int d = 0; d < DB; ++d) {
                bf16x8 va[2][2];
#pragma unroll
                for (int kb = 0; kb < 2; ++kb)
#pragma unroll
                    for (int s = 0; s < 2; ++s) {
                        const unsigned char* vp = Vs + (kb * 32 + 16 * s + 4 * h + q4) * C::VSTR + ((dvh * 4 + d) * 32 + 16 * (grp & 1) + 4 * pp) * 2;
                        s4v lo = tr_read(vp), hi = tr_read(vp + 8 * C::VSTR);
                        va[kb][s] = __builtin_shufflevector(lo, hi, 0, 1, 2, 3, 4, 5, 6, 7);
                    }
                __builtin_amdgcn_sched_barrier(0);
#pragma unroll
                for (int kb = 0; kb < 2; ++kb)
#pragma unroll
                    for (int s = 0; s < 2; ++s) O[d] = __builtin_amdgcn_mfma_f32_32x32x16_bf16(va[kb][s], pf[kb][s], O[d], 0, 0, 0);
            }
        }
      }
    }
    if (MODE == 0 || MODE == 1) {
        float inv = 1.f;
        if constexpr (MODE == 1) { const float l = lrun + __shfl_xor(lrun, 32); inv = 1.f / l; }
        if (wactive && qvalid) {
            bf16_t* op = (MODE == 0) ? (bf16_t*)(p.ws + WS_R1 + R1_MIXED) + orow * 1024 + hd * 64
                                     : (bf16_t*)(p.ws + WS_R1 + R1_MIXED2) + orow * 1024 + 512 + hd * 64;
#pragma unroll
            for (int d = 0; d < DB; ++d)
#pragma unroll
                for (int g = 0; g < 4; ++g) {
                    u32x2 w; w.x = pk2(O[d][4 * g] * inv, O[d][4 * g + 1] * inv); w.y = pk2(O[d][4 * g + 2] * inv, O[d][4 * g + 3] * inv);
                    *(u32x2*)(op + d * 32 + 8 * g + 4 * h) = w;
                }
        }
    } else {
        const float l = lrun + __shfl_xor(lrun, 32);
        const float inv = 1.f / l;
        __syncthreads();
        float* OL = (float*)smem;
        if (wactive) {
            const int rr = rg * 32 + r;
#pragma unroll
            for (int d = 0; d < DB; ++d)
#pragma unroll
                for (int g = 0; g < 4; ++g)
                    *(f32x4*)(OL + rr * 256 + (dvh * 4 + d) * 32 + 8 * g + 4 * h) = (f32x4){O[d][4 * g] * inv, O[d][4 * g + 1] * inv, O[d][4 * g + 2] * inv, O[d][4 * g + 3] * inv};
        }
        __syncthreads();
        const int hh = tid >> 6, v = tid & 63;
        const float* wuv = p.in[23] + (size_t)hh * 256 * 64 + v;
        float acc[16];
#pragma unroll
        for (int t = 0; t < 16; ++t) acc[t] = 0.f;
        for (int c = 0; c < 256; ++c) {
            const float w = wuv[(size_t)c * 64];
#pragma unroll
            for (int t = 0; t < 16; ++t) acc[t] += OL[(hh * 16 + t) * 256 + c] * w;
        }
        bf16_t* MX = (bf16_t*)(p.ws + WS_R1 + R1_MIXED2);
#pragma unroll
        for (int t = 0; t < 16; ++t) MX[(size_t)(NP + b * 16 + t) * 1024 + 512 + hh * 64 + v] = f2bf(acc[t]);
    }
}

#define XB_TMO      128
#define XB_XCNT(j)  (256  + 64 * (j))
#define XB_XSUB(j)  (1280 + 64 * (j))
#define XB_XGEN(j)  (2304 + 64 * (j))
#define XB_TOP      3328
#define XB_TOPGEN   3392
#define XCD_BAR_WORDS 3456
#define XB_SPIN_CAP (1u << 21)
DEVI unsigned xb_ld(unsigned* p)              { return __hip_atomic_load(p, __ATOMIC_RELAXED, __HIP_MEMORY_SCOPE_AGENT); }
DEVI unsigned xb_add(unsigned* p, unsigned v) { return __hip_atomic_fetch_add(p, v, __ATOMIC_RELAXED, __HIP_MEMORY_SCOPE_AGENT); }
DEVI unsigned xb_xcc_id() { return (unsigned)__builtin_amdgcn_s_getreg((3 << 11) | 20) & 0xFu; }
#define XB_SPIN(cond, bar) do { unsigned _sp = 0; while (cond) { __builtin_amdgcn_s_sleep(1); \
    if ((++_sp & 255u) == 0u) { if (xb_ld(&(bar)[XB_TMO])) break; if (_sp > XB_SPIN_CAP) { atomicAdd(&(bar)[XB_TMO], 1u); break; } } } } while (0)
struct XcdBarrier { unsigned* bar; unsigned x; volatile LAS unsigned* st; };
DEVI XcdBarrier xcd_barrier_post(unsigned* bar, volatile LAS unsigned* st) {
    XcdBarrier b; b.bar = bar; b.x = xb_xcc_id(); b.st = st;
    if (threadIdx.x == 0) (void)xb_add(&bar[XB_XCNT(b.x)], 1u);
    return b;
}
DEVI void xcd_barrier_complete(unsigned* bar, unsigned x, unsigned& nloc, unsigned& nx) {
    const unsigned G = gridDim.x * gridDim.y * gridDim.z;
    unsigned sum, cnt, mine, sp = 0u;
    for (;;) {
        sum = 0u; cnt = 0u; mine = 0u;
#pragma unroll
        for (unsigned j = 0; j < 16; ++j) { const unsigned c = xb_ld(&bar[XB_XCNT(j)]); sum += c; cnt += (c > 0u) ? 1u : 0u; mine = (j == x) ? c : mine; }
        if (sum == G) break;
        __builtin_amdgcn_s_sleep(1);
        if ((++sp & 255u) == 0u) { if (xb_ld(&bar[XB_TMO])) break; if (sp > XB_SPIN_CAP) { atomicAdd(&bar[XB_TMO], 1u); break; } }
    }
    nloc = mine > 0u ? mine : 1u; nx = cnt > 0u ? cnt : 1u;
}
DEVI void xcd_barrier(const XcdBarrier& b) {
    asm volatile("s_waitcnt vmcnt(0)" ::: "memory");
    __syncthreads();
    if (threadIdx.x == 0) {
        unsigned* bar = b.bar;
        __builtin_amdgcn_s_waitcnt(0);
        unsigned nloc = b.st[0], nx = b.st[1];
        if (nloc == 0u) { xcd_barrier_complete(bar, b.x, nloc, nx); b.st[0] = nloc; b.st[1] = nx; }
        const unsigned old = xb_add(&bar[XB_XSUB(b.x)], 1u);
        const unsigned gen = old / nloc;
        if (old + 1u == (gen + 1u) * nloc) {
            __builtin_amdgcn_fence(__ATOMIC_RELEASE, "agent");
            asm volatile("s_waitcnt vmcnt(0)" ::: "memory");
            const unsigned og = xb_add(&bar[XB_TOP], 1u);
            const unsigned tg = og / nx;
            if (og + 1u == (tg + 1u) * nx) xb_add(&bar[XB_TOPGEN], 1u);
            else XB_SPIN(xb_ld(&bar[XB_TOPGEN]) == tg, bar);
            __builtin_amdgcn_fence(__ATOMIC_ACQUIRE, "agent");
            xb_add(&bar[XB_XGEN(b.x)], 1u);
            asm volatile("s_waitcnt vmcnt(0)" ::: "memory");
        } else {
            XB_SPIN(xb_ld(&bar[XB_XGEN(b.x)]) == gen, bar);
            __builtin_amdgcn_fence(__ATOMIC_ACQUIRE, "agent");
            asm volatile("s_waitcnt vmcnt(0)" ::: "memory");
        }
    }
    __syncthreads();
}

DEVI int next_item(unsigned* ctr, int* slot) {
    __syncthreads();
    if (threadIdx.x == 0) *slot = (int)atomicAdd(ctr, 1u);
    __syncthreads();
    return *slot;
}

__global__ void __launch_bounds__(512) mega(Params p, int ph_lo, int ph_hi, int coop) {
    __shared__ __attribute__((aligned(16))) unsigned char smem[131072 + 64];
    int* const s_item_p = (int*)(smem + 131072);
    unsigned* const xbw = (unsigned*)(smem + 131072 + 16);
    if (threadIdx.x == 0) { xbw[0] = 0u; xbw[1] = 0u; xbw[2] = 0u; xbw[3] = 0u; }
    __syncthreads();
    XcdBarrier xb = xcd_barrier_post((unsigned*)(p.ws + WS_CTR), (volatile LAS unsigned*)xbw);
    unsigned* ctr = (unsigned*)(p.ws + WS_CTR);
    bf16_t* shm = (bf16_t*)smem;
    unsigned char* ws = p.ws;
    bf16_t* H = (bf16_t*)(ws + WS_H);
    bf16_t* Ob = (bf16_t*)(ws + WS_O);
    bf16_t* R1 = (bf16_t*)(ws + WS_R1);

    for (int ph = ph_lo; ph < ph_hi; ++ph) {
        if (ph > ph_lo && coop) { if (ph == 1) cg::this_grid().sync(); else xcd_barrier(xb); }
        const int layer = ph >= 8 ? 1 : 0;
        constexpr int rep = 0;
        switch (ph) {
        case 0: phase_prep(p, (float*)smem); break;
        case 1: {
            bf16_t* Q = R1;
            const bf16_t* W = (const bf16_t*)(ws + WS_W1T);
            auto emit = [&](int row, int col, f32x4 v0, f32x4 v1) { bf16_t* d = Q + (size_t)row * 3072 + col; st_bf16x8(d, v0, v1); };
            gemm_run<16>(H, 1024, W, 1024, 1024, shm, [&](int i, int& br, int& bc) { const int it = blockIdx.x + i * gridDim.x; if (it >= 256 * 12) return false; int pm, pn; tile_map(it, 256, 12, pm, pn); br = pm * 256; bc = pn * 256; return true; }, emit);
            for (int it = blockIdx.x; it < 8 * 48; it += gridDim.x) gemm_small<8>(H, 1024, W, 1024, 1024, NP + (it & 7) * 64, (it >> 3) * 64, (float*)smem, emit);
        } break;
        case 2: {
            for (;;) {
                const int it = next_item(ctr + 0 + 2 * rep, s_item_p);
                if (it >= 2304 + 2064 + 1152) break;
                if (it >= 2304 + 2064) { kc_item(p, it - (2304 + 2064)); continue; }
                if (it < 2 * 2064) { if (it & 1) conv_item(p, it >> 1); else attn_item<0>(p, it >> 1, smem); }
                else attn_item<0>(p, it - 2064, smem);
            }
        } break;
        case 3: case 12: {
            const bf16_t* A = R1 + (layer ? R1_MIXED2 : R1_MIXED) / 2;
            const bf16_t* W = (const bf16_t*)(ws + (layer ? WS_WO2T : WS_WO1T));
            auto emit = [&](int row, int col, f32x4 v0, f32x4 v1) { bf16_t* d = Ob + (size_t)row * 1024 + col; st_bf16x8(d, v0, v1); };
            gemm_run<16>(A, 1024, W, 1024, 1024, shm, [&](int i, int& br, int& bc) { const int it = blockIdx.x + i * gridDim.x; if (it >= 256 * 4) return false; int pm, pn; tile_map(it, 256, 4, pm, pn); br = pm * 256; bc = pn * 256; return true; }, emit);
            for (int it = blockIdx.x; it < 8 * 16; it += gridDim.x) gemm_small<8>(A, 1024, W, 1024, 1024, NP + (it & 7) * 64, (it >> 3) * 64, (float*)smem, emit);
        } break;
        case 4: phase_rowpass(p, false, p.in[8], false); break;
        case 13: phase_rowpass(p, false, p.in[8] + 1024, false); break;
        case 5: case 14: {
            bf16_t* ACT = R1;
            const bf16_t* W = (const bf16_t*)(ws + (layer ? WS_WUP1 : WS_WUP0));
            auto emit = [&](int row, int col, f32x4 v0, f32x4 v1) {
#pragma unroll
                for (int k = 0; k < 4; ++k) { float a = fmaxf(v0[k], 0.f), b2 = fmaxf(v1[k], 0.f); v0[k] = a * a; v1[k] = b2 * b2; }
                bf16_t* d = ACT + (size_t)row * 4096 + col; st_bf16x8(d, v0, v1);
            };
            gemm_run<16>(H, 1024, W, 1024, 1024, shm, [&](int i, int& br, int& bc) { const int it = blockIdx.x + i * gridDim.x; if (it >= 256 * 16) return false; int pm, pn; tile_map(it, 256, 16, pm, pn); br = pm * 256; bc = pn * 256; return true; }, emit);
            for (int it = blockIdx.x; it < 8 * 64; it += gridDim.x) gemm_small<8>(H, 1024, W, 1024, 1024, NP + (it & 7) * 64, (it >> 3) * 64, (float*)smem, emit);
        } break;
        case 6: case 15: {
            const bf16_t* ACT = R1;
            const bf16_t* W = (const bf16_t*)(ws + (layer ? WS_WDN1 : WS_WDN0));
            auto emit = [&](int row, int col, f32x4 v0, f32x4 v1) { bf16_t* d = Ob + (size_t)row * 1024 + col; st_bf16x8(d, v0, v1); };
            gemm_run<16>(ACT, 4096, W, 4096, 4096, shm, [&](int i, int& br, int& bc) { if (i >= 4) return false; const int it = blockIdx.x + (3 - i) * gridDim.x;     int pm, pn; tile_map(it, 256, 4, pm, pn); br = pm * 256; bc = pn * 256; return true; }, emit);
            for (int it = blockIdx.x; it < 8 * 16; it += gridDim.x) gemm_small<8>(ACT, 4096, W, 4096, 4096, NP + (it & 7) * 64, (it >> 3) * 64, (float*)smem, emit);
        } break;
        case 7: phase_rowpass(p, false, p.in[10], false); break;
        case 16: phase_rowpass(p, false, p.in[10] + 1024, true); break;
        case 8: {
            bf16_t* IN1 = R1;
            const bf16_t* W = (const bf16_t*)(ws + WS_W2T);
            auto emit = [&](int row, int col, f32x4 v0, f32x4 v1) { bf16_t* d = IN1 + (size_t)row * 1792 + col; st_bf16x8(d, v0, v1); };
            gemm_run<16>(H, 1024, W, 1024, 1024, shm, [&](int i, int& br, int& bc) { const int it = blockIdx.x + i * gridDim.x; if (it >= 256 * 7) return false; int pm, pn; tile_map(it, 256, 7, pm, pn); br = pm * 256; bc = pn * 256; return true; }, emit);
            for (int it = blockIdx.x; it < 8 * 28; it += gridDim.x) gemm_small<8>(H, 1024, W, 1024, 1024, NP + (it & 7) * 64, (it >> 3) * 64, (float*)smem, emit);
        } break;
        case 9: phase_l1rows(p); break;
        case 10: {
            const bf16_t* IN1 = R1;
            bf16_t* QF = R1 + R1_QF / 2; bf16_t* KVUP = R1 + R1_KVUP / 2; bf16_t* QLAT = R1 + R1_QLAT / 2;
            auto emit_kv = [&](int row, int col, f32x4 v0, f32x4 v1) { bf16_t* d = KVUP + (size_t)row * 1024 + col; st_bf16x8(d, v0, v1); };
            auto emit_qf = [&](int row, int col, f32x4 v0, f32x4 v1) { bf16_t* d = QF + (size_t)row * 768 + col; st_bf16x8(d, v0, v1); };
            auto emit_ql = [&](int row, int col, f32x4 v0, f32x4 v1) { bf16_t* d = QLAT + (size_t)(row - NP) * 2048 + col; st_bf16x8(d, v0, v1); };
            gemm_run<0>(IN1 + 1408, 1792, (const bf16_t*)(ws + WS_WKVT), 256, 256, shm, [&](int i, int& br, int& bc) { const int it = blockIdx.x + i * gridDim.x; if (it >= 256 * 4) return false; int pm, pn; tile_map(it, 256, 4, pm, pn); br = pm * 256; bc = pn * 256; return true; }, emit_kv);
            gemm_run<0>(IN1 + 1024, 1792, (const bf16_t*)(ws + WS_WUQT), 384, 384, shm, [&](int i, int& br, int& bc) { const int it = blockIdx.x + i * gridDim.x; if (it >= 256 * 3) return false; int pm, pn; tile_map(it, 256, 3, pm, pn); br = pm * 256; bc = pn * 256; return true; }, emit_qf);
            for (int it = blockIdx.x; it < 8 * 12 + 8 * 32; it += gridDim.x) {
                if (it < 96) gemm_small<4>(IN1 + 1024, 1792, (const bf16_t*)(ws + WS_WUQT), 384, 384, NP + (it & 7) * 64, (it >> 3) * 64, (float*)smem, emit_qf);
                else { const int i2 = it - 96; gemm_small<4>(IN1 + 1024, 1792, (const bf16_t*)(ws + WS_WQLT), 384, 384, NP + (i2 & 7) * 64, (i2 >> 3) * 64, (float*)smem, emit_ql); }
            }
        } break;
        case 11: {
            for (;;) {
                int it = next_item(ctr + 1 + 2 * rep, s_item_p);
                if (it >= 32 + 2048 + 2176) break;
                if (it < 32) attn_item<2>(p, it, smem);
                else {
                    const int i2 = it - 32;
                    if (i2 < 2 * 2048) { if (i2 & 1) sgu_item(p, i2 >> 1, smem); else attn_item<1>(p, i2 >> 1, smem); }
                    else sgu_item(p, i2 - 2048, smem);
                }
            }
        } break;
        default: break;
        }
    }
}

constexpr int NPHASE = 17;

extern "C" void kernel_launch(void* const* d_in, const int* in_sizes, int n_in, void* d_out, int out_size, void* d_ws, size_t ws_size, hipStream_t stream) {
    static int grid = 0;
    if (grid == 0) {
        int dev = 0, cus = 0, per_cu = 0;
        hipGetDevice(&dev);
        hipDeviceGetAttribute(&cus, hipDeviceAttributeMultiprocessorCount, dev);
        hipOccupancyMaxActiveBlocksPerMultiprocessor(&per_cu, mega, 512, 0);
        if (per_cu < 1) per_cu = 1;
        grid = cus * 1;
        if (ws_size < WS_END) { fprintf(stderr, "kernel_launch: workspace too small: %zu < %zu\n", ws_size, (size_t)WS_END); grid = -1; }
    }
    if (grid < 0) return;
    Params p{};
    for (int i = 0; i < 27; ++i) p.in[i] = (const float*)d_in[i];
    p.out = (float*)d_out; p.ws = (unsigned char*)d_ws;
    hipMemsetAsync(d_ws, 0, 16384, stream);
#ifdef MULTI_LAUNCH
    for (int ph = 0; ph < NPHASE; ++ph) hipLaunchKernelGGL(mega, dim3(grid), dim3(512), 0, stream, p, ph, ph + 1, 0);
#else
    int lo = 0, hi = NPHASE, coop = 1;
    void* args[] = {&p, &lo, &hi, &coop};
    hipError_t e = hipLaunchCooperativeKernel((void*)mega, dim3(grid), dim3(512), args, 0, stream);
    if (e != hipSuccess) fprintf(stderr, "cooperative launch failed: %s (grid %d)\n", hipGetErrorString(e), grid);
#endif
}
```
